# Optimizing an MI355X kernel written in HIP

```python
import math
import jax, jax.numpy as jnp
from jax import lax
import numpy as np

D_MODEL = 2048
BATCH = 2
SEQ = 4096
DEPTH = 1

D_MIX = D_MODEL
D_NSA = D_MIX // 2
D_CONV = D_MIX - D_NSA
HEAD_DIM = 64
N_HEADS = D_NSA // HEAD_DIM
N_KV = 4
HPG = N_HEADS // N_KV
CMP_LEN = 32
CMP_STRIDE = 16
CMP_HIDDEN = 256
SLC_LEN = 64
N_SLC_SEL = 16
WINDOW = 512
Q_BLOCK = 128
FORCE_BONUS = 1.0e4
CONV_WIDTH = 31
PEER_HEADS = 8
N_KEYS = 128
N_EXPERTS = N_KEYS * N_KEYS
PK_DIM = 256
PK_HALF = PK_DIM // 2
PK_TOPK = 16
PEER_BLOCK = 128
Q_COLS = N_HEADS * HEAD_DIM
KV_COLS = 6 * N_KV * HEAD_DIM
GATE_COLS = 3 * N_HEADS
CONV_COLS = 2 * D_CONV
D_IN = Q_COLS + KV_COLS + GATE_COLS + CONV_COLS
LN_EPS = 1e-5
DN_ALPHA = (2 * DEPTH) ** 0.25
DN_BETA = (8 * DEPTH) ** -0.25

kernel_name = "hybrid_nsa_conformer_peer_block"


def layer_norm(x, g, b):
    xf = x.astype(jnp.float32)
    mu = jnp.mean(xf, axis=-1, keepdims=True)
    var = jnp.mean(jnp.square(xf - mu), axis=-1, keepdims=True)
    return ((xf - mu) * lax.rsqrt(var + LN_EPS) * g + b).astype(x.dtype)


def masked_softmax(s, mask):
    s = jnp.where(mask, s.astype(jnp.float32), -1e30)
    p = jax.nn.softmax(s, axis=-1)
    return jnp.where(mask, p, 0.0)


def alibi_slopes():
    sl = 2.0 ** (-8.0 * np.arange(1, N_HEADS + 1) / N_HEADS)
    return jnp.asarray(sl, jnp.float32).reshape(N_KV, HPG)


def compress_kv(kv, pos, w1, w2):
    bsz, seq = kv.shape[0], kv.shape[1]
    n_cmp = (seq - CMP_LEN) // CMP_STRIDE + 1
    idx = np.arange(n_cmp)[:, None] * CMP_STRIDE + np.arange(CMP_LEN)[None, :]
    blk = kv[:, idx] + pos[:, None, :]
    blk = jnp.transpose(blk, (0, 1, 3, 2, 4)).reshape(bsz, n_cmp, N_KV, CMP_LEN * HEAD_DIM)
    return jax.nn.gelu(blk @ w1) @ w2


def nsa_group(q, k_c, v_c, k_s, v_s, k_w, v_w, gates, pos_k, w1k, w2k, pos_v, w1v, w2v):
    bsz, seq = q.shape[0], q.shape[1]
    scale = HEAD_DIM ** -0.5
    slopes = alibi_slopes()
    kc = compress_kv(k_c, pos_k, w1k, w2k)
    vc = compress_kv(v_c, pos_v, w1v, w2v)
    n_cmp = kc.shape[1]
    n_slc = seq // SLC_LEN
    n_sel = min(N_SLC_SEL, n_slc)
    cmp_start = np.arange(n_cmp) * CMP_STRIDE
    cmp_end = cmp_start + CMP_LEN - 1
    slc_start = np.arange(n_slc) * SLC_LEN
    overlap = ((cmp_start[:, None] < slc_start[None, :] + SLC_LEN) &
               (cmp_start[:, None] + CMP_LEN > slc_start[None, :])).astype(np.float32)
    ks_blk = jnp.transpose(k_s.reshape(bsz, n_slc, SLC_LEN, N_KV, HEAD_DIM), (0, 3, 1, 2, 4))
    vs_blk = jnp.transpose(v_s.reshape(bsz, n_slc, SLC_LEN, N_KV, HEAD_DIM), (0, 3, 1, 2, 4))
    kw_pad = jnp.pad(k_w, ((0, 0), (WINDOW, 0), (0, 0), (0, 0)))
    vw_pad = jnp.pad(v_w, ((0, 0), (WINDOW, 0), (0, 0), (0, 0)))
    b_ix = jnp.arange(bsz)[:, None, None, None]
    g_ix = jnp.arange(N_KV)[None, None, :, None]
    jb = jnp.arange(n_slc)

    def block(j):
        t0 = j * Q_BLOCK
        qb = lax.dynamic_slice_in_dim(q, t0, Q_BLOCK, axis=1)
        gb = lax.dynamic_slice_in_dim(gates, t0, Q_BLOCK, axis=1).reshape(bsz, Q_BLOCK, N_KV, HPG, 3)
        tpos = t0 + jnp.arange(Q_BLOCK)
        dist_c = (tpos[:, None] - cmp_end[None, :]).astype(jnp.float32)
        s = jnp.einsum('bqghd,bngd->bghqn', qb, kc) * scale
        s = s - slopes[None, :, :, None, None] * dist_c
        p_c = masked_softmax(s, cmp_end[None, :] <= tpos[:, None])
        o_cmp = jnp.einsum('bghqn,bngd->bqghd', p_c, vc)
        imp = jnp.einsum('bghqn,nj->bqgj', p_c, overlap)
        cur = tpos // SLC_LEN
        forced = (jb[None, :] == 0) | (jb[None, :] == cur[:, None]) | (jb[None, :] == cur[:, None] - 1)
        imp = jnp.where(forced[None, :, None, :], imp + FORCE_BONUS, imp)
        imp = jnp.where((slc_start[None, :] <= tpos[:, None])[None, :, None, :], imp, -1.0)
        _, sel = lax.top_k(imp, n_sel)
        kg = ks_blk[b_ix, g_ix, sel]
        vg = vs_blk[b_ix, g_ix, sel]
        spos = sel[..., None] * SLC_LEN + jnp.arange(SLC_LEN)
        dist_s = (tpos[None, :, None, None, None] - spos).astype(jnp.float32)
        s = jnp.einsum('bqghd,bqgkld->bqghkl', qb, kg) * scale
        s = s - slopes[None, None, :, :, None, None] * dist_s[:, :, :, None]
        valid = jnp.broadcast_to((dist_s >= 0)[:, :, :, None], s.shape)
        p_s = masked_softmax(s.reshape(s.shape[:4] + (-1,)), valid.reshape(s.shape[:4] + (-1,)))
        o_slc = jnp.einsum('bqghkl,bqgkld->bqghd', p_s.reshape(s.shape), vg)
        kwb = lax.dynamic_slice_in_dim(kw_pad, t0, WINDOW + Q_BLOCK, axis=1)
        vwb = lax.dynamic_slice_in_dim(vw_pad, t0, WINDOW + Q_BLOCK, axis=1)
        wpos = t0 - WINDOW + jnp.arange(WINDOW + Q_BLOCK)
        dw = tpos[:, None] - wpos[None, :]
        mask_w = (dw >= 0) & (dw < WINDOW) & (wpos[None, :] >= 0)
        s = jnp.einsum('bqghd,bsgd->bghqs', qb, kwb) * scale
        s = s - slopes[None, :, :, None, None] * dw.astype(jnp.float32)
        p_w = masked_softmax(s, mask_w)
        o_win = jnp.einsum('bghqs,bsgd->bqghd', p_w, vwb)
        return gb[..., 0:1] * o_cmp + gb[..., 1:2] * o_slc + gb[..., 2:3] * o_win

    out = lax.map(block, jnp.arange(seq // Q_BLOCK))
    return jnp.transpose(out, (1, 0, 2, 3, 4, 5)).reshape(bsz, seq, D_NSA)


def conformer_conv_group(ab, dw_w, dw_b, ln_g, ln_b):
    a, gate = jnp.split(ab, 2, axis=-1)
    u = a * jax.nn.sigmoid(gate)
    u = jnp.pad(u, ((0, 0), (CONV_WIDTH - 1, 0), (0, 0)))
    c = lax.conv_general_dilated(u, dw_w[:, None, :], window_strides=(1,), padding='VALID',
                                 dimension_numbers=('NWC', 'WIO', 'NWC'),
                                 feature_group_count=D_CONV) + dw_b
    return jax.nn.silu(layer_norm(c, ln_g, ln_b))


def peer_ffn(y, wq, sub_keys, u_tab, v_tab):
    bsz, seq = y.shape[0], y.shape[1]
    yb_all = jnp.transpose(y.reshape(bsz, seq // PEER_BLOCK, PEER_BLOCK, D_MODEL), (1, 0, 2, 3))

    def block(yb):
        q = (yb @ wq).reshape(bsz, PEER_BLOCK, PEER_HEADS, 2, PK_HALF)
        s1 = jnp.einsum('bthd,hkd->bthk', q[..., 0, :], sub_keys[:, 0])
        s2 = jnp.einsum('bthd,hkd->bthk', q[..., 1, :], sub_keys[:, 1])
        v1, i1 = lax.top_k(s1, PK_TOPK)
        v2, i2 = lax.top_k(s2, PK_TOPK)
        cand = (v1[..., :, None] + v2[..., None, :]).reshape(bsz, PEER_BLOCK, PEER_HEADS, PK_TOPK * PK_TOPK)
        cidx = (i1[..., :, None] * N_KEYS + i2[..., None, :]).reshape(cand.shape)
        top, pos = lax.top_k(cand, PK_TOPK)
        eidx = jnp.take_along_axis(cidx, pos, axis=-1)
        g = jax.nn.softmax(top.astype(jnp.float32), axis=-1)
        u = u_tab[eidx]
        v = v_tab[eidx]
        h = jax.nn.gelu(jnp.einsum('btd,bthkd->bthk', yb, u))
        return jnp.einsum('bthk,bthkd->btd', g * h, v).astype(y.dtype)

    out = lax.map(block, yb_all)
    return jnp.transpose(out, (1, 0, 2, 3)).reshape(bsz, seq, D_MODEL)


def setup_inputs(seed: int = 0) -> dict:
    key = jax.random.key(seed)
    ks = jax.random.split(key, 24)
    f32 = jnp.float32
    L = DEPTH
    def nrm(k, shape, scale):
        return jax.random.normal(k, shape, f32) * scale
    return {
        "x": nrm(ks[0], (BATCH, SEQ, D_MODEL), 1.0),
        "w_in": nrm(ks[1], (L, D_MODEL, D_IN), D_MODEL ** -0.5),
        "cmp_pos_k": nrm(ks[2], (L, CMP_LEN, HEAD_DIM), 0.1),
        "cmp_w1_k": nrm(ks[3], (L, CMP_LEN * HEAD_DIM, CMP_HIDDEN), (CMP_LEN * HEAD_DIM) ** -0.5),
        "cmp_w2_k": nrm(ks[4], (L, CMP_HIDDEN, HEAD_DIM), CMP_HIDDEN ** -0.5),
        "cmp_pos_v": nrm(ks[5], (L, CMP_LEN, HEAD_DIM), 0.1),
        "cmp_w1_v": nrm(ks[6], (L, CMP_LEN * HEAD_DIM, CMP_HIDDEN), (CMP_LEN * HEAD_DIM) ** -0.5),
        "cmp_w2_v": nrm(ks[7], (L, CMP_HIDDEN, HEAD_DIM), CMP_HIDDEN ** -0.5),
        "dw_w": nrm(ks[8], (L, CONV_WIDTH, D_CONV), CONV_WIDTH ** -0.5),
        "dw_b": nrm(ks[9], (L, D_CONV), 0.02),
        "conv_ln_g": 1.0 + nrm(ks[10], (L, D_CONV), 0.02),
        "conv_ln_b": nrm(ks[11], (L, D_CONV), 0.02),
        "w_out": nrm(ks[12], (L, D_MIX, D_MODEL), D_MIX ** -0.5 * DN_BETA),
        "ln1_g": 1.0 + nrm(ks[13], (L, D_MODEL), 0.02),
        "ln1_b": nrm(ks[14], (L, D_MODEL), 0.02),
        "peer_wq": nrm(ks[15], (L, D_MODEL, PEER_HEADS * PK_DIM), D_MODEL ** -0.5),
        "peer_keys": nrm(ks[16], (L, PEER_HEADS, 2, N_KEYS, PK_HALF), PK_HALF ** -0.5),
        "peer_u": nrm(ks[17], (L, N_EXPERTS, D_MODEL), D_MODEL ** -0.5),
        "peer_v": nrm(ks[18], (L, N_EXPERTS, D_MODEL), DN_BETA * PEER_HEADS ** -0.5),
        "ln2_g": 1.0 + nrm(ks[19], (L, D_MODEL), 0.02),
        "ln2_b": nrm(ks[20], (L, D_MODEL), 0.02),
    }


def reference(x, w_in, cmp_pos_k, cmp_w1_k, cmp_w2_k, cmp_pos_v, cmp_w1_v, cmp_w2_v,
              dw_w, dw_b, conv_ln_g, conv_ln_b, w_out, ln1_g, ln1_b,
              peer_wq, peer_keys, peer_u, peer_v, ln2_g, ln2_b):
    bsz, seq = x.shape[0], x.shape[1]
    splits = [Q_COLS, Q_COLS + KV_COLS, Q_COLS + KV_COLS + GATE_COLS]
    for l in range(DEPTH):
        h = x @ w_in[l]
        q, kv, gl, conv_ab = jnp.split(h, splits, axis=-1)
        q = q.reshape(bsz, seq, N_KV, HPG, HEAD_DIM)
        kv = kv.reshape(bsz, seq, 6, N_KV, HEAD_DIM)
        gates = jax.nn.sigmoid(gl).reshape(bsz, seq, N_HEADS, 3)
        o_nsa = nsa_group(q, kv[:, :, 0], kv[:, :, 1], kv[:, :, 2], kv[:, :, 3], kv[:, :, 4], kv[:, :, 5],
                          gates, cmp_pos_k[l], cmp_w1_k[l], cmp_w2_k[l],
                          cmp_pos_v[l], cmp_w1_v[l], cmp_w2_v[l]).astype(x.dtype)
        o_conv = conformer_conv_group(conv_ab, dw_w[l], dw_b[l], conv_ln_g[l], conv_ln_b[l]).astype(x.dtype)
        mix = jnp.concatenate([o_nsa, o_conv], axis=-1) @ w_out[l]
        x = layer_norm(DN_ALPHA * x + mix, ln1_g[l], ln1_b[l])
        ffn = peer_ffn(x, peer_wq[l], peer_keys[l], peer_u[l], peer_v[l])
        x = layer_norm(DN_ALPHA * x + ffn, ln2_g[l], ln2_b[l])
    return x
```

```cpp
#include <hip/hip_runtime.h>
#include <hip/hip_cooperative_groups.h>
#include <cstdio>
namespace cg = cooperative_groups;

typedef unsigned short u16;
typedef unsigned long long u64;
using bf16x8 = __attribute__((ext_vector_type(8))) short;
using f32x4  = __attribute__((ext_vector_type(4))) float;
#define DI __device__ __forceinline__
#define MFMA16(a, b, c) __builtin_amdgcn_mfma_f32_16x16x32_bf16((a), (b), (c), 0, 0, 0)

#ifndef N_LAUNCH_MODE
#define N_LAUNCH_MODE 1
#endif

constexpr int D_MODEL = 2048, SEQ = 4096, NTOK = 8192;
constexpr int D_IN = 4656, HS = 4736;
constexpr int COL_KV = 1024, COL_GATE = 2560, COL_CONV = 2608;
constexpr float DN_ALPHA = 1.189207115002721f;
constexpr float LN_EPS = 1e-5f;
constexpr int NPHASE = 9;

struct Params {
  const float *x, *w_in, *pos_k, *w1_k, *w2_k, *pos_v, *w1_v, *w2_v, *dw_w, *dw_b, *cln_g, *cln_b,
      *w_out, *ln1_g, *ln1_b, *wq, *pkeys, *pu, *pv, *ln2_g, *ln2_b;
  float* out;
  u16 *XB, *WINT, *WOUTT, *WQT, *W1KT, *W1VT, *W2KT, *W2VT, *PKEYS, *UB, *VB, *H, *VT, *KC, *VCT, *MIXB, *YB, *PQ;
  float *BIAS, *Y, *GW, *USC, *VSC;
  int* EIDX;
  unsigned* BAR;
  long long phase_lo, phase_hi;
};

typedef __bf16 bf16x2_hw __attribute__((ext_vector_type(2)));
typedef float f32x2_hw __attribute__((ext_vector_type(2)));
DI unsigned pack2(float lo, float hi) {
  const f32x2_hw v = {lo, hi};
  return __builtin_bit_cast(unsigned, __builtin_convertvector(v, bf16x2_hw));
}
DI u16 f2bf(float x) { return (u16)(pack2(x, 0.f) & 0xffffu); }
DI float bf2f(u16 b) { return __uint_as_float(((unsigned)b) << 16); }
DI float bflo(unsigned u) { return __uint_as_float(u << 16); }
DI float bfhi(unsigned u) { return __uint_as_float(u & 0xffff0000u); }
DI float sigmoidf_(float x) { return __builtin_amdgcn_rcpf(1.0f + __expf(-x)); }
DI float gelu_tanh(float x) {
  float z = 0.7978845608028654f * (x + 0.044715f * x * x * x);
  float t = 1.0f - 2.0f * __builtin_amdgcn_rcpf(__expf(2.0f * z) + 1.0f);
  return 0.5f * x * (1.0f + t);
}
DI float q16f(float v, bool sum) {
  auto r = __builtin_amdgcn_permlane16_swap(__float_as_uint(v), __float_as_uint(v), false, false);
  const float a = __uint_as_float(r[0]), b = __uint_as_float(r[1]);
  return sum ? a + b : fmaxf(a, b);
}
DI float q32f(float v, bool sum) {
  auto r = __builtin_amdgcn_permlane32_swap(__float_as_uint(v), __float_as_uint(v), false, false);
  const float a = __uint_as_float(r[0]), b = __uint_as_float(r[1]);
  return sum ? a + b : fmaxf(a, b);
}
DI float quad_maxf(float v) { return q32f(q16f(v, false), false); }
DI float quad_sumf(float v) { return q32f(q16f(v, true), true); }
DI int quad_maxi(int v) {
  auto r = __builtin_amdgcn_permlane16_swap((unsigned)v, (unsigned)v, false, false);
  v = max((int)r[0], (int)r[1]);
  auto s = __builtin_amdgcn_permlane32_swap((unsigned)v, (unsigned)v, false, false);
  return max((int)s[0], (int)s[1]);
}
DI int quad_mini(int v) {
  auto r = __builtin_amdgcn_permlane16_swap((unsigned)v, (unsigned)v, false, false);
  v = min((int)r[0], (int)r[1]);
  auto s = __builtin_amdgcn_permlane32_swap((unsigned)v, (unsigned)v, false, false);
  return min((int)s[0], (int)s[1]);
}
template <int CTRL> DI float dppf(float v) { return __int_as_float(__builtin_amdgcn_update_dpp(0, __float_as_int(v), CTRL, 0xf, 0xf, false)); }
DI float wave_sum(float v) {
  v += dppf<0xB1>(v);
  v += dppf<0x4E>(v);
  v += dppf<0x141>(v);
  v += dppf<0x140>(v);
  return quad_sumf(v);
}
template <int CTRL> DI unsigned dppu(unsigned v) { return (unsigned)__builtin_amdgcn_update_dpp(0, (int)v, CTRL, 0xf, 0xf, false); }
DI float wave_max(float v) {
  v = fmaxf(v, dppf<0xB1>(v)); v = fmaxf(v, dppf<0x4E>(v)); v = fmaxf(v, dppf<0x141>(v)); v = fmaxf(v, dppf<0x140>(v));
  return quad_maxf(v);
}
DI unsigned row_or(unsigned v) {
  v |= dppu<0xB1>(v); v |= dppu<0x4E>(v); v |= dppu<0x141>(v); v |= dppu<0x140>(v);
  return v;
}
DI float block_sum(float v, float* red) {
  v = wave_sum(v);
  if ((threadIdx.x & 63) == 0) red[threadIdx.x >> 6] = v;
  __syncthreads();
  float r = red[0] + red[1] + red[2] + red[3];
  __syncthreads();
  return r;
}
DI bf16x8 ld8(const u16* p) { return *(const bf16x8*)p; }
DI bf16x8 comb(uint2 lo, uint2 hi) {
  uint4 v = make_uint4(lo.x, lo.y, hi.x, hi.y);
  return __builtin_bit_cast(bf16x8, v);
}
DI bf16x8 packp(f32x4 a, f32x4 b) {
  uint4 v = make_uint4(pack2(a[0], a[1]), pack2(a[2], a[3]), pack2(b[0], b[1]), pack2(b[2], b[3]));
  return __builtin_bit_cast(bf16x8, v);
}

#define XB_TMO      128
#define XB_XCNT(j)  (256  + 64 * (j))
#define XB_XSUB(j)  (1280 + 64 * (j))
#define XB_XGEN(j)  (2304 + 64 * (j))
#define XB_TOP      3328
#define XB_TOPGEN   3392
#define XCD_BAR_WORDS 3456
#define XB_SPIN_CAP (1u << 22)
#define LAS __attribute__((address_space(3)))
DI unsigned xb_ld(unsigned* p)              { return __hip_atomic_load(p, __ATOMIC_RELAXED, __HIP_MEMORY_SCOPE_AGENT); }
DI unsigned xb_add(unsigned* p, unsigned v) { return __hip_atomic_fetch_add(p, v, __ATOMIC_RELAXED, __HIP_MEMORY_SCOPE_AGENT); }
DI unsigned xb_xcc_id() { return (unsigned)__builtin_amdgcn_s_getreg((3 << 11) | 20) & 0xFu; }
#define XB_SPIN(cond, bar) do { unsigned _sp = 0; while (cond) { __builtin_amdgcn_s_sleep(1); \
    if ((++_sp & 255u) == 0u) { if (xb_ld(&(bar)[XB_TMO])) break; if (_sp > XB_SPIN_CAP) { (void)xb_add(&(bar)[XB_TMO], 1u); break; } } } } while (0)
struct XcdBarrier { unsigned* bar; unsigned x; volatile LAS unsigned* st; };
DI XcdBarrier xcd_barrier_post(unsigned* bar, volatile LAS unsigned* st) {
  XcdBarrier b; b.bar = bar; b.x = xb_xcc_id(); b.st = st;
  if (threadIdx.x == 0) (void)xb_add(&bar[XB_XCNT(b.x)], 1u);
  return b;
}
DI void xcd_barrier_complete(unsigned* bar, unsigned x, unsigned& nloc, unsigned& nx) {
  const unsigned G = gridDim.x * gridDim.y * gridDim.z;
  unsigned sum, cnt, mine, sp = 0u;
  for (;;) {
    sum = 0u; cnt = 0u; mine = 0u;
#pragma unroll 1
    for (unsigned j = 0; j < 16; ++j) { const unsigned c = xb_ld(&bar[XB_XCNT(j)]); sum += c; cnt += (c > 0u) ? 1u : 0u; mine = (j == x) ? c : mine; }
    if (sum == G) break;
    __builtin_amdgcn_s_sleep(1);
    if ((++sp & 255u) == 0u) { if (xb_ld(&bar[XB_TMO])) break; if (sp > XB_SPIN_CAP) { (void)xb_add(&bar[XB_TMO], 1u); break; } }
  }
  nloc = mine > 0u ? mine : 1u; nx = cnt > 0u ? cnt : 1u;
}
DI void xcd_barrier(unsigned* const bar, volatile LAS unsigned* const bst) {
  const unsigned bx = xb_xcc_id();
  asm volatile("s_waitcnt vmcnt(0)" ::: "memory");
  __syncthreads();
  if (threadIdx.x == 0) {
    __builtin_amdgcn_s_waitcnt(0);
    unsigned nloc = bst[0], nx = bst[1];
    if (nloc == 0u) { xcd_barrier_complete(bar, bx, nloc, nx); bst[0] = nloc; bst[1] = nx; }
    const unsigned old = xb_add(&bar[XB_XSUB(bx)], 1u);
    const unsigned gen = old / nloc;
    if (old + 1u == (gen + 1u) * nloc) {
      __builtin_amdgcn_fence(__ATOMIC_RELEASE, "agent");
      asm volatile("s_waitcnt vmcnt(0)" ::: "memory");
      const unsigned og = xb_add(&bar[XB_TOP], 1u);
      const unsigned tg = og / nx;
      if (og + 1u == (tg + 1u) * nx) xb_add(&bar[XB_TOPGEN], 1u);
      else XB_SPIN(xb_ld(&bar[XB_TOPGEN]) == tg, bar);
      __builtin_amdgcn_fence(__ATOMIC_ACQUIRE, "agent");
      xb_add(&bar[XB_XGEN(bx)], 1u);
      asm volatile("s_waitcnt vmcnt(0)" ::: "memory");
    } else {
      XB_SPIN(xb_ld(&bar[XB_XGEN(bx)]) == gen, bar);
      __builtin_amdgcn_fence(__ATOMIC_ACQUIRE, "agent");
      asm volatile("s_waitcnt vmcnt(0)" ::: "memory");
    }
  }
  __syncthreads();
}

DI void cvt_f32_bf16(const float* __restrict__ src, u16* __restrict__ dst, size_t n8) {
  size_t i = (size_t)blockIdx.x * 256 + threadIdx.x, stride = (size_t)gridDim.x * 256;
  for (; i < n8; i += stride) {
    float4 a = ((const float4*)src)[2 * i], b = ((const float4*)src)[2 * i + 1];
    uint4 o = make_uint4(pack2(a.x, a.y), pack2(a.z, a.w), pack2(b.x, b.y), pack2(b.z, b.w));
    ((uint4*)dst)[i] = o;
  }
}
DI void transpose_cvt(const float* __restrict__ src, int R, int C, u16* __restrict__ dst, int Cpad, float* tile, int bid, int nb) {
  const int tid = threadIdx.x;
  const int tr = R / 64, tc = Cpad / 64;
  for (int it = bid; it < tr * tc; it += nb) {
    const int r0 = (it / tc) * 64, c0 = (it % tc) * 64;
#pragma unroll
    for (int ps = 0; ps < 4; ++ps) {
      int r = ps * 16 + (tid >> 4), c = (tid & 15) * 4;
      float4 v = make_float4(0.f, 0.f, 0.f, 0.f);
      if (c0 + c < C) v = *(const float4*)(src + (size_t)(r0 + r) * C + c0 + c);
      tile[(c + 0) * 65 + r] = v.x; tile[(c + 1) * 65 + r] = v.y; tile[(c + 2) * 65 + r] = v.z; tile[(c + 3) * 65 + r] = v.w;
    }
    __syncthreads();
    {
      int c = tid >> 2, part = tid & 3;
      const float* tp = tile + c * 65 + part * 16;
      uint4 o0 = make_uint4(pack2(tp[0], tp[1]), pack2(tp[2], tp[3]), pack2(tp[4], tp[5]), pack2(tp[6], tp[7]));
      uint4 o1 = make_uint4(pack2(tp[8], tp[9]), pack2(tp[10], tp[11]), pack2(tp[12], tp[13]), pack2(tp[14], tp[15]));
      uint4* dp = (uint4*)(dst + (size_t)(c0 + c) * R + r0 + part * 16);
      dp[0] = o0; dp[1] = o1;
    }
    __syncthreads();
  }
}

typedef float v32f __attribute__((ext_vector_type(32)));
typedef _Float16 v32h __attribute__((ext_vector_type(32)));
typedef unsigned v6u __attribute__((ext_vector_type(6)));
constexpr int ROWB = 1536;
DI void quant_rows_fp6(const float* __restrict__ src, unsigned char* __restrict__ dst, float* __restrict__ sc, int row0, int nrows) {
  const int lane = threadIdx.x & 63;
  for (int row = row0 + (threadIdx.x >> 6); row < row0 + nrows; row += 4) {
    const float* sp = src + (size_t)row * 2048 + lane * 32;
    float4 v[8];
    float am = 0.f;
#pragma unroll
    for (int j = 0; j < 8; ++j) {
      float4 t = *(const float4*)(sp + j * 4);
      v[j] = t;
      am = fmaxf(am, fmaxf(fmaxf(fabsf(t.x), fabsf(t.y)), fmaxf(fabsf(t.z), fabsf(t.w))));
    }
    am = wave_max(am);
    const float scale = am > 0.f ? 7.0f / am : 1.0f;
    if (lane == 0) sc[row] = am > 0.f ? am * (1.0f / 7.0f) : 1.0f;
    v32h h;
#pragma unroll
    for (int j = 0; j < 8; ++j) {
      h[j * 4 + 0] = (_Float16)(v[j].x * scale); h[j * 4 + 1] = (_Float16)(v[j].y * scale);
      h[j * 4 + 2] = (_Float16)(v[j].z * scale); h[j * 4 + 3] = (_Float16)(v[j].w * scale);
    }
    const v6u q = __builtin_amdgcn_cvt_scalef32_pk32_fp6_f16(h, 1.0f);
    unsigned char* dp = dst + (size_t)row * ROWB;
    *(uint4*)(dp + lane * 16) = make_uint4(q[0], q[1], q[2], q[3]);
    *(uint2*)(dp + 1024 + lane * 8) = make_uint2(q[4], q[5]);
  }
}

DI void phase_prep(const Params& p, float* lds) {
  cvt_f32_bf16(p.x, p.XB, (size_t)NTOK * D_MODEL / 8);
  for (int o = blockIdx.x * 256 + threadIdx.x; o < 16 * 8 * 4 * 64; o += gridDim.x * 256) {
    const int ln = o & 63, ks = (o >> 6) & 3, kt = (o >> 8) & 7, hc = o >> 11;
    const float* ksrc = p.pkeys + ((size_t)(hc * 128 + kt * 16 + (ln & 15))) * 128 + ks * 32 + (ln >> 4) * 8;
    const float4 a = *(const float4*)ksrc, b = *(const float4*)(ksrc + 4);
    *(uint4*)(p.PKEYS + (size_t)o * 8) = make_uint4(pack2(a.x, a.y), pack2(a.z, a.w), pack2(b.x, b.y), pack2(b.z, b.w));
  }
  transpose_cvt(p.w_in, 2048, D_IN, p.WINT, HS, lds, blockIdx.x, gridDim.x);
  for (int o = blockIdx.x * 256 + threadIdx.x; o < 2 * 65536; o += gridDim.x * 256) {
    const int kind = o >> 16, r = o & 65535;
    const int ln = r & 63, t = (r >> 6) & 15, ks = r >> 10;
    const float* wsrc = (kind ? p.w1_v : p.w1_k) + (size_t)(ks * 32 + (ln >> 4) * 8) * 256 + t * 16 + (ln & 15);
    uint4 v = make_uint4(pack2(wsrc[0], wsrc[256]), pack2(wsrc[512], wsrc[768]), pack2(wsrc[1024], wsrc[1280]), pack2(wsrc[1536], wsrc[1792]));
    *(uint4*)((kind ? p.W1VT : p.W1KT) + (size_t)r * 8) = v;
  }
  transpose_cvt(p.w2_k, 256, 64, p.W2KT, 64, lds, blockIdx.x, gridDim.x);
  transpose_cvt(p.w2_v, 256, 64, p.W2VT, 64, lds, blockIdx.x, gridDim.x);
}

constexpr int LDS_ROW = 72;
template <class Epi>
DI void gemm_tile(const u16* __restrict__ P, int ldp, const u16* __restrict__ Q, int ldq, int K,
                          int p0, int q0, u16* lds, Epi epi) {
  const int tid = threadIdx.x, lane = tid & 63, w = tid >> 6;
  const int wp = w & 1, wq = w >> 1;
  const int l15 = lane & 15, quad = lane >> 4;
  u16* sP = lds;
  u16* sQ = lds + 128 * LDS_ROW;
  f32x4 acc[4][4];
#pragma unroll
  for (int i = 0; i < 4; ++i)
#pragma unroll
    for (int j = 0; j < 4; ++j) acc[i][j] = f32x4{0.f, 0.f, 0.f, 0.f};
  const int srow = tid >> 3, scc = tid & 7;
  const u16* gp = P + (size_t)(p0 + srow) * ldp + scc * 8;
  const u16* gq = Q + (size_t)(q0 + srow) * ldq + scc * 8;
  const u16* gp1 = gp + (size_t)32 * ldp; const u16* gp2 = gp + (size_t)64 * ldp; const u16* gp3 = gp + (size_t)96 * ldp;
  const u16* gq1 = gq + (size_t)32 * ldq; const u16* gq2 = gq + (size_t)64 * ldq; const u16* gq3 = gq + (size_t)96 * ldq;
  uint4 rp0 = *(const uint4*)gp, rp1 = *(const uint4*)gp1, rp2 = *(const uint4*)gp2, rp3 = *(const uint4*)gp3;
  uint4 rq0 = *(const uint4*)gq, rq1 = *(const uint4*)gq1, rq2 = *(const uint4*)gq2, rq3 = *(const uint4*)gq3;
  uint4 sp0 = *(const uint4*)(gp + 64), sp1 = *(const uint4*)(gp1 + 64), sp2 = *(const uint4*)(gp2 + 64), sp3 = *(const uint4*)(gp3 + 64);
  uint4 sq0 = *(const uint4*)(gq + 64), sq1 = *(const uint4*)(gq1 + 64), sq2 = *(const uint4*)(gq2 + 64), sq3 = *(const uint4*)(gq3 + 64);
  u16* wP = sP + srow * LDS_ROW + scc * 8;
  u16* wQ = sQ + srow * LDS_ROW + scc * 8;
  const int nkt = K / 64;
#define GEMM_COMPUTE() \
  _Pragma("unroll") for (int ks = 0; ks < 2; ++ks) { \
    bf16x8 a[4], b[4]; \
    _Pragma("unroll") for (int i = 0; i < 4; ++i) { \
      a[i] = *(const bf16x8*)(sP + (wp * 64 + i * 16 + l15) * LDS_ROW + ks * 32 + quad * 8); \
      b[i] = *(const bf16x8*)(sQ + (wq * 64 + i * 16 + l15) * LDS_ROW + ks * 32 + quad * 8); } \
    _Pragma("unroll") for (int i = 0; i < 4; ++i) \
      _Pragma("unroll") for (int j = 0; j < 4; ++j) acc[i][j] = MFMA16(a[i], b[j], acc[i][j]); }
  for (int kt = 0; kt < nkt; kt += 2) {
    *(uint4*)(wP) = rp0; *(uint4*)(wP + 32 * LDS_ROW) = rp1; *(uint4*)(wP + 64 * LDS_ROW) = rp2; *(uint4*)(wP + 96 * LDS_ROW) = rp3;
    *(uint4*)(wQ) = rq0; *(uint4*)(wQ + 32 * LDS_ROW) = rq1; *(uint4*)(wQ + 64 * LDS_ROW) = rq2; *(uint4*)(wQ + 96 * LDS_ROW) = rq3;
    __syncthreads();
    if (kt + 2 < nkt) {
      const int ko = (kt + 2) * 64;
      rp0 = *(const uint4*)(gp + ko); rp1 = *(const uint4*)(gp1 + ko); rp2 = *(const uint4*)(gp2 + ko); rp3 = *(const uint4*)(gp3 + ko);
      rq0 = *(const uint4*)(gq + ko); rq1 = *(const uint4*)(gq1 + ko); rq2 = *(const uint4*)(gq2 + ko); rq3 = *(const uint4*)(gq3 + ko);
    }
    GEMM_COMPUTE()
    __syncthreads();
    *(uint4*)(wP) = sp0; *(uint4*)(wP + 32 * LDS_ROW) = sp1; *(uint4*)(wP + 64 * LDS_ROW) = sp2; *(uint4*)(wP + 96 * LDS_ROW) = sp3;
    *(uint4*)(wQ) = sq0; *(uint4*)(wQ + 32 * LDS_ROW) = sq1; *(uint4*)(wQ + 64 * LDS_ROW) = sq2; *(uint4*)(wQ + 96 * LDS_ROW) = sq3;
    __syncthreads();
    if (kt + 3 < nkt) {
      const int ko = (kt + 3) * 64;
      sp0 = *(const uint4*)(gp + ko); sp1 = *(const uint4*)(gp1 + ko); sp2 = *(const uint4*)(gp2 + ko); sp3 = *(const uint4*)(gp3 + ko);
      sq0 = *(const uint4*)(gq + ko); sq1 = *(const uint4*)(gq1 + ko); sq2 = *(const uint4*)(gq2 + ko); sq3 = *(const uint4*)(gq3 + ko);
    }
    GEMM_COMPUTE()
    __syncthreads();
  }
#undef GEMM_COMPUTE
#pragma unroll
  for (int i = 0; i < 4; ++i)
#pragma unroll
    for (int j = 0; j < 4; ++j)
      epi(p0 + wp * 64 + i * 16 + quad * 4, q0 + wq * 64 + j * 16 + l15, acc[i][j]);
}

template <class Epi>
DI void gemm_tile_big(const u16* __restrict__ P, int ldp, const u16* __restrict__ Q, int ldq, int K,
                      int p0, int q0, u16* lds, Epi epi) {
  const int tid = threadIdx.x, lane = tid & 63, w = tid >> 6;
  const int wp = w & 1, wq = w >> 1;
  const int l15 = lane & 15, quad = lane >> 4;
  u16* sP = lds;
  u16* sQ = lds + 128 * LDS_ROW;
  f32x4 acc[4][8];
#pragma unroll
  for (int i = 0; i < 4; ++i)
#pragma unroll
    for (int j = 0; j < 8; ++j) acc[i][j] = f32x4{0.f, 0.f, 0.f, 0.f};
  const int srow = tid >> 3, scc = tid & 7;
  const u16* gp = P + (size_t)(p0 + srow) * ldp + scc * 8;
  const u16* gq = Q + (size_t)(q0 + srow) * ldq + scc * 8;
  const size_t sp32 = (size_t)32 * ldp, sq32 = (size_t)32 * ldq;
  uint4 rp0 = *(const uint4*)gp, rp1 = *(const uint4*)(gp + sp32), rp2 = *(const uint4*)(gp + 2 * sp32), rp3 = *(const uint4*)(gp + 3 * sp32);
  uint4 rq0 = *(const uint4*)gq, rq1 = *(const uint4*)(gq + sq32), rq2 = *(const uint4*)(gq + 2 * sq32), rq3 = *(const uint4*)(gq + 3 * sq32);
  uint4 rq4 = *(const uint4*)(gq + 4 * sq32), rq5 = *(const uint4*)(gq + 5 * sq32), rq6 = *(const uint4*)(gq + 6 * sq32), rq7 = *(const uint4*)(gq + 7 * sq32);
  u16* wP = sP + srow * LDS_ROW + scc * 8;
  u16* wQ = sQ + srow * LDS_ROW + scc * 8;
  const int nkt = K / 64;
  for (int kt = 0; kt < nkt; ++kt) {
    *(uint4*)(wP) = rp0; *(uint4*)(wP + 32 * LDS_ROW) = rp1; *(uint4*)(wP + 64 * LDS_ROW) = rp2; *(uint4*)(wP + 96 * LDS_ROW) = rp3;
    *(uint4*)(wQ) = rq0; *(uint4*)(wQ + 32 * LDS_ROW) = rq1; *(uint4*)(wQ + 64 * LDS_ROW) = rq2; *(uint4*)(wQ + 96 * LDS_ROW) = rq3;
    *(uint4*)(wQ + 128 * LDS_ROW) = rq4; *(uint4*)(wQ + 160 * LDS_ROW) = rq5; *(uint4*)(wQ + 192 * LDS_ROW) = rq6; *(uint4*)(wQ + 224 * LDS_ROW) = rq7;
    __syncthreads();
    if (kt + 1 < nkt) {
      const int ko = (kt + 1) * 64;
      rp0 = *(const uint4*)(gp + ko); rp1 = *(const uint4*)(gp + sp32 + ko); rp2 = *(const uint4*)(gp + 2 * sp32 + ko); rp3 = *(const uint4*)(gp + 3 * sp32 + ko);
      rq0 = *(const uint4*)(gq + ko); rq1 = *(const uint4*)(gq + sq32 + ko); rq2 = *(const uint4*)(gq + 2 * sq32 + ko); rq3 = *(const uint4*)(gq + 3 * sq32 + ko);
      rq4 = *(const uint4*)(gq + 4 * sq32 + ko); rq5 = *(const uint4*)(gq + 5 * sq32 + ko); rq6 = *(const uint4*)(gq + 6 * sq32 + ko); rq7 = *(const uint4*)(gq + 7 * sq32 + ko);
    }
    {
#define LDA_(dst, ks) _Pragma("unroll") for (int i = 0; i < 4; ++i) dst[i] = *(const bf16x8*)(sP + (wp * 64 + i * 16 + l15) * LDS_ROW + (ks) * 32 + quad * 8)
#define LDB_(dst, ks, jh) _Pragma("unroll") for (int j = 0; j < 4; ++j) dst[j] = *(const bf16x8*)(sQ + (wq * 128 + ((jh) * 4 + j) * 16 + l15) * LDS_ROW + (ks) * 32 + quad * 8)
#define MM_(a, b, jh) do { __builtin_amdgcn_s_setprio(1); _Pragma("unroll") for (int i = 0; i < 4; ++i) _Pragma("unroll") for (int j = 0; j < 4; ++j) acc[i][(jh) * 4 + j] = MFMA16(a[i], b[j], acc[i][(jh) * 4 + j]); __builtin_amdgcn_s_setprio(0); } while (0)
#define SCHED_ __builtin_amdgcn_sched_barrier(0)
      bf16x8 a[4], b0[4], b1[4];
      LDA_(a, 0); LDB_(b0, 0, 0); LDB_(b1, 0, 1);
      SCHED_;
      MM_(a, b0, 0);
      SCHED_;
      LDB_(b0, 1, 0);
      SCHED_;
      MM_(a, b1, 1);
      SCHED_;
      LDA_(a, 1); LDB_(b1, 1, 1);
      SCHED_;
      MM_(a, b0, 0);
      SCHED_;
      MM_(a, b1, 1);
#undef LDA_
#undef LDB_
#undef MM_
#undef SCHED_
    }
    __syncthreads();
  }
#pragma unroll
  for (int i = 0; i < 4; ++i)
#pragma unroll
    for (int j = 0; j < 8; ++j)
      epi(p0 + wp * 64 + i * 16 + quad * 4, q0 + wq * 128 + j * 16 + l15, acc[i][j]);
}

template <class Epi>
DI void gemm_tile_glds(const u16* __restrict__ P, int ldp, const u16* __restrict__ Q, int ldq, int K,
                       int p0, int q0, unsigned char* lds, Epi epi) {
  const int tid = threadIdx.x, lane = tid & 63, w = tid >> 6;
  const int wp = w & 1, wq = w >> 1;
  const int l15 = lane & 15, quad = lane >> 4;
  f32x4 acc[4][4];
#pragma unroll
  for (int i = 0; i < 4; ++i)
#pragma unroll
    for (int j = 0; j < 4; ++j) acc[i][j] = f32x4{0.f, 0.f, 0.f, 0.f};
  const int srow = w * 8 + (lane >> 3);
  const int csrc = (lane & 7) ^ ((srow >> 1) & 7);
  const u16* gp = P + (size_t)(p0 + srow) * ldp + csrc * 8;
  const u16* gq = Q + (size_t)(q0 + srow) * ldq + csrc * 8;
  const unsigned dP = (unsigned)__builtin_amdgcn_readfirstlane((int)(unsigned)(size_t)(lds + (w * 8) * 128));
  const unsigned dQ = dP + 16384u;
#define GLDS16(gsrc_, ldsb_) do { unsigned keep_; \
    asm volatile("s_mov_b32 %0, m0\n\ts_mov_b32 m0, %2\n\ts_nop 0\n\tglobal_load_lds_dwordx4 %1, off\n\ts_mov_b32 m0, %0" \
                 : "=&s"(keep_) : "v"(gsrc_), "s"(ldsb_) : "memory"); } while (0)
#define GLDS_ISSUE(kt_, buf_) do { \
    _Pragma("unroll") for (int j = 0; j < 4; ++j) { \
      GLDS16(gp + (size_t)(32 * j) * ldp + (kt_) * 64, dP + (unsigned)(j * 4096 + (buf_) * 32768)); \
      GLDS16(gq + (size_t)(32 * j) * ldq + (kt_) * 64, dQ + (unsigned)(j * 4096 + (buf_) * 32768)); } } while (0)
  GLDS_ISSUE(0, 0);
  const int nkt = K / 64;
  const int sw = l15 >> 1;
  const unsigned char* rP = lds + (wp * 64 + l15) * 128;
  const unsigned char* rQ = lds + 16384 + (wq * 64 + l15) * 128;
  for (int kt = 0; kt < nkt; ++kt) {
    asm volatile("s_waitcnt vmcnt(0)" ::: "memory");
    __builtin_amdgcn_s_barrier();
    if (kt + 1 < nkt) GLDS_ISSUE(kt + 1, (kt + 1) & 1);
    const int bo = (kt & 1) * 32768;
#pragma unroll
    for (int ks = 0; ks < 2; ++ks) {
      const int co = ((ks * 4 + quad) ^ sw) * 16;
      bf16x8 a[4], b[4];
#pragma unroll
      for (int i = 0; i < 4; ++i) {
        a[i] = *(const bf16x8*)(rP + bo + i * 2048 + co);
        b[i] = *(const bf16x8*)(rQ + bo + i * 2048 + co);
      }
#pragma unroll
      for (int i = 0; i < 4; ++i)
#pragma unroll
        for (int j = 0; j < 4; ++j) acc[i][j] = MFMA16(a[i], b[j], acc[i][j]);
    }
  }
#undef GLDS_ISSUE
#undef GLDS16
  __syncthreads();
  if constexpr (Epi::kPairRows) {
#pragma unroll
    for (int j = 0; j < 4; ++j)
#pragma unroll
      for (int i = 0; i < 4; i += 2) {
        const unsigned alo = pack2(acc[i][j][0], acc[i][j][1]), ahi = pack2(acc[i][j][2], acc[i][j][3]);
        const unsigned blo = pack2(acc[i + 1][j][0], acc[i + 1][j][1]), bhi = pack2(acc[i + 1][j][2], acc[i + 1][j][3]);
        auto rl = __builtin_amdgcn_permlane16_swap(alo, blo, false, false);
        auto rh = __builtin_amdgcn_permlane16_swap(ahi, bhi, false, false);
        epi.store8(p0 + wp * 64 + (i + (quad & 1)) * 16 + (quad >> 1) * 8, q0 + wq * 64 + j * 16 + l15, make_uint4(rl[0], rh[0], rl[1], rh[1]));
      }
  } else {
#pragma unroll
    for (int i = 0; i < 4; ++i)
#pragma unroll
      for (int j = 0; j < 4; ++j)
        epi(p0 + wp * 64 + i * 16 + quad * 4, q0 + wq * 64 + j * 16 + l15, acc[i][j]);
  }
}

struct EpiH {
  static constexpr bool kPairRows = true;
  u16* H;
  DI void store8(int pch, int tok, uint4 v) const { *(uint4*)(H + (size_t)tok * HS + pch) = v; }
  DI void operator()(int pch, int tok, f32x4 v) const {
    *(uint2*)(H + (size_t)tok * HS + pch) = make_uint2(pack2(v[0], v[1]), pack2(v[2], v[3]));
  }
};
struct EpiVT {
  static constexpr bool kPairRows = true;
  u16* VT;
  DI void store8(int tok, int ch, uint4 v) const {
    int which = (ch >= 2304) ? 1 : 0;
    int cc = ch & 255;
    int g = cc >> 6, d = cc & 63;
    int b = tok >> 12, t = tok & 4095;
    *(uint4*)(VT + ((size_t)((which * 2 + b) * 4 + g) * 64 + d) * 4096 + t) = v;
  }
  DI void operator()(int tok, int ch, f32x4 v) const {
    int which = (ch >= 2304) ? 1 : 0;
    int cc = ch & 255;
    int g = cc >> 6, d = cc & 63;
    int b = tok >> 12, t = tok & 4095;
    *(uint2*)(VT + ((size_t)((which * 2 + b) * 4 + g) * 64 + d) * 4096 + t) = make_uint2(pack2(v[0], v[1]), pack2(v[2], v[3]));
  }
};
struct EpiMix {
  static constexpr bool kPairRows = false;
  float* Y; const float* x;
  DI void operator()(int c, int tok, f32x4 v) const {
    float4 xv = *(const float4*)(x + (size_t)tok * 2048 + c);
    *(float4*)(Y + (size_t)tok * 2048 + c) = make_float4(DN_ALPHA * xv.x + v[0], DN_ALPHA * xv.y + v[1], DN_ALPHA * xv.z + v[2], DN_ALPHA * xv.w + v[3]);
  }
};
struct EpiPQ {
  static constexpr bool kPairRows = true;
  u16* PQ;
  DI void store8(int c, int tok, uint4 v) const {
    const size_t off = ((((size_t)(tok >> 4) * 16 + (c >> 7)) * 4 + ((c >> 5) & 3)) * 64 + ((c >> 3) & 3) * 16 + (tok & 15)) * 8;
    *(uint4*)(PQ + off) = v;
  }
  DI void operator()(int c, int tok, f32x4 v) const {
    const size_t off = ((((size_t)(tok >> 4) * 16 + (c >> 7)) * 4 + ((c >> 5) & 3)) * 64 + ((c >> 3) & 3) * 16 + (tok & 15)) * 8 + (c & 7);
    *(uint2*)(PQ + off) = make_uint2(pack2(v[0], v[1]), pack2(v[2], v[3]));
  }
};

DI void phase_gemm1(const Params& p, u16* lds, volatile LAS unsigned* bcast) {
  for (;;) {
    if (threadIdx.x == 0) bcast[2] = xb_add(&p.BAR[0], 1u);
    __syncthreads();
    const int it = (int)bcast[2];
    __syncthreads();
    if (it >= 37 * 64) break;
    const int ct = it % 37, tt = it / 37;
    const bool isv = (ct == 14 || ct == 15 || ct == 18 || ct == 19);
    if (isv) gemm_tile_glds(p.XB, 2048, p.WINT, 2048, 2048, tt * 128, ct * 128, (unsigned char*)lds, EpiVT{p.VT});
    else     gemm_tile_glds(p.WINT, 2048, p.XB, 2048, 2048, ct * 128, tt * 128, (unsigned char*)lds, EpiH{p.H});
  }
}
DI void phase_gemm_mix(const Params& p, u16* lds) {
  for (int it = blockIdx.x; it < 16 * 64; it += gridDim.x) {
    int ct = it % 16, tt = it / 16;
    gemm_tile_glds(p.WOUTT, 2048, p.MIXB, 2048, 2048, ct * 128, tt * 128, (unsigned char*)lds, EpiMix{p.Y, p.x});
  }
}
DI void phase_gemm_pq(const Params& p, u16* lds) {
  for (int it = blockIdx.x; it < 16 * 64; it += gridDim.x) {
    int ct = it % 16, tt = it / 16;
    gemm_tile_glds(p.WQT, 2048, p.YB, 2048, 2048, ct * 128, tt * 128, (unsigned char*)lds, EpiPQ{p.PQ});
  }
}

DI bf16x8 add_pos(bf16x8 v, float4 a, float4 b) {
  uint4 u = __builtin_bit_cast(uint4, v);
  uint4 r = make_uint4(pack2(bflo(u.x) + a.x, bfhi(u.x) + a.y), pack2(bflo(u.y) + a.z, bfhi(u.y) + a.w),
                       pack2(bflo(u.z) + b.x, bfhi(u.z) + b.y), pack2(bflo(u.w) + b.z, bfhi(u.w) + b.w));
  return __builtin_bit_cast(bf16x8, r);
}
DI void compress_item(const Params& p, int item, u16* hid  ) {
  const int tid = threadIdx.x, lane = tid & 63, w = tid >> 6;
  const int l15 = lane & 15, quad = lane >> 4;
  const int kind = item >> 6;
  const int r0 = (item & 63) * 32;
  const u16* W1T = kind ? p.W1VT : p.W1KT;
  const u16* W2T = kind ? p.W2VT : p.W2KT;
  const float* posp = (kind ? p.pos_v : p.pos_k) + quad * 8;
  const u16* brow[2];
#pragma unroll
  for (int qi = 0; qi < 2; ++qi) {
    int r = r0 + qi * 16 + l15;
    if (r > 2039) r = 2039;
    int g = r & 3, bn = r >> 2;
    int b = bn / 255, n = bn % 255;
    brow[qi] = p.H + (size_t)(b * 4096 + 16 * n) * HS + COL_KV + kind * 256 + g * 64 + quad * 8;
  }
  const u16* arow = W1T + ((size_t)(w * 4) * 64 + lane) * 8;
  f32x4 acc[4][2];
#pragma unroll
  for (int i = 0; i < 4; ++i) { acc[i][0] = f32x4{0.f, 0.f, 0.f, 0.f}; acc[i][1] = f32x4{0.f, 0.f, 0.f, 0.f}; }
#pragma unroll 4
  for (int ks = 0; ks < 64; ++ks) {
    const int l = ks >> 1, d0 = (ks & 1) * 32;
    const float4 pa = *(const float4*)(posp + l * 64 + d0), pb4 = *(const float4*)(posp + l * 64 + d0 + 4);
    bf16x8 b0 = add_pos(ld8(brow[0] + (size_t)l * HS + d0), pa, pb4);
    bf16x8 b1 = add_pos(ld8(brow[1] + (size_t)l * HS + d0), pa, pb4);
#pragma unroll
    for (int i = 0; i < 4; ++i) {
      bf16x8 a = ld8(arow + (size_t)(ks * 16 + i) * 512);
      acc[i][0] = MFMA16(a, b0, acc[i][0]);
      acc[i][1] = MFMA16(a, b1, acc[i][1]);
    }
  }
#pragma unroll
  for (int i = 0; i < 4; ++i)
#pragma unroll
    for (int qi = 0; qi < 2; ++qi) {
      int j = w * 64 + i * 16 + quad * 4;
      float h0 = gelu_tanh(acc[i][qi][0]), h1 = gelu_tanh(acc[i][qi][1]);
      float h2 = gelu_tanh(acc[i][qi][2]), h3 = gelu_tanh(acc[i][qi][3]);
      *(uint2*)(hid + (qi * 16 + l15) * 264 + j) = make_uint2(pack2(h0, h1), pack2(h2, h3));
    }
  __syncthreads();
  f32x4 o2[2] = {f32x4{0.f, 0.f, 0.f, 0.f}, f32x4{0.f, 0.f, 0.f, 0.f}};
#pragma unroll
  for (int ks = 0; ks < 8; ++ks) {
    bf16x8 a = ld8(W2T + (size_t)(w * 16 + l15) * 256 + ks * 32 + quad * 8);
#pragma unroll
    for (int qi = 0; qi < 2; ++qi) {
      bf16x8 b = *(const bf16x8*)(hid + (qi * 16 + l15) * 264 + ks * 32 + quad * 8);
      o2[qi] = MFMA16(a, b, o2[qi]);
    }
  }
#pragma unroll
  for (int qi = 0; qi < 2; ++qi) {
    int r = r0 + qi * 16 + l15;
    if (r < 2040) {
      int g = r & 3, bn = r >> 2;
      int b = bn / 255, n = bn % 255;
      int d = w * 16 + quad * 4;
      if (kind == 0) {
        *(uint2*)(p.KC + ((((size_t)(b * 4 + g) * 16 + (n >> 4)) * 2 + (d >> 5)) * 64 + ((d >> 3) & 3) * 16 + (n & 15)) * 8 + (d & 7)) = make_uint2(pack2(o2[qi][0], o2[qi][1]), pack2(o2[qi][2], o2[qi][3]));
      } else {
        const int m = n & 31;
        u16* vp = p.VCT + (((((size_t)(b * 4 + g) * 4 + (n >> 6)) * 2 + ((n >> 5) & 1)) * 4 + (d >> 4)) * 64 + ((m & 15) >> 2) * 16 + (d & 15)) * 8 + (m & 3) + ((m >> 4) << 2);
        vp[0] = f2bf(o2[qi][0]); vp[8] = f2bf(o2[qi][1]); vp[16] = f2bf(o2[qi][2]); vp[24] = f2bf(o2[qi][3]);
      }
    }
  }
  if ((item & 63) == 0) {
    if (kind == 0) {
      if (tid < 8 * 64) { int bg = tid >> 5;   (void)bg; }
      for (int e = tid; e < 8 * 64; e += 256) { const int bg = e >> 6, dd = e & 63; p.KC[((((size_t)bg * 16 + 15) * 2 + (dd >> 5)) * 64 + ((dd >> 3) & 3) * 16 + 15) * 8 + (dd & 7)] = 0; }
    } else {
      for (int e = tid; e < 8 * 64; e += 256) { const int bg = e >> 6, dd = e & 63; p.VCT[(((((size_t)bg * 4 + 3) * 2 + 1) * 4 + (dd >> 4)) * 64 + 3 * 16 + (dd & 15)) * 8 + 7] = 0; }
    }
  }
  __syncthreads();
}

constexpr int CT = 16;
DI void conv_item(const Params& p, int item, float* red) {
  const int tid = threadIdx.x;
  const int tok0 = item * CT;
  const int t0 = tok0 & 4095;
  const int c = tid * 4;
  float res[CT][4];
  {
    float4 bv = *(const float4*)(p.dw_b + c);
#pragma unroll
    for (int o = 0; o < CT; ++o) { res[o][0] = bv.x; res[o][1] = bv.y; res[o][2] = bv.z; res[o][3] = bv.w; }
  }
  {
    const int tt0 = (t0 >= 30) ? 0 : (30 - t0);
    const u16* hp = p.H + (size_t)(tok0 - 30 + tt0) * HS + COL_CONV + c;
    const float* wp = p.dw_w + c;
    float4 wr[CT];
#pragma unroll
    for (int o = 0; o < CT; ++o) {
      const int tap = tt0 - o;
      wr[o] = (tap >= 0 && tap <= 30) ? *(const float4*)(wp + tap * 1024) : make_float4(0.f, 0.f, 0.f, 0.f);
    }
#pragma unroll 8
    for (int tt = tt0; tt < 30 + CT; ++tt, hp += HS) {
      const uint2 av = *(const uint2*)hp;
      const uint2 gv = *(const uint2*)(hp + 1024);
      const float4 wnext = (tt + 1 <= 30) ? *(const float4*)(wp + (tt + 1) * 1024) : make_float4(0.f, 0.f, 0.f, 0.f);
      const float u0 = bflo(av.x) * sigmoidf_(bflo(gv.x));
      const float u1 = bfhi(av.x) * sigmoidf_(bfhi(gv.x));
      const float u2 = bflo(av.y) * sigmoidf_(bflo(gv.y));
      const float u3 = bfhi(av.y) * sigmoidf_(bfhi(gv.y));
#pragma unroll
      for (int o = 0; o < CT; ++o) {
        res[o][0] += wr[o].x * u0;
        res[o][1] += wr[o].y * u1;
        res[o][2] += wr[o].z * u2;
        res[o][3] += wr[o].w * u3;
      }
#pragma unroll
      for (int o = CT - 1; o > 0; --o) wr[o] = wr[o - 1];
      wr[0] = wnext;
    }
  }
  float mu[CT], rs[CT];
  {
    const int lane = tid & 63, w = tid >> 6;
#pragma unroll
    for (int o = 0; o < CT; ++o) {
      const float s = wave_sum(res[o][0] + res[o][1] + res[o][2] + res[o][3]);
      if (lane == 0) red[w * CT + o] = s;
    }
    __syncthreads();
#pragma unroll
    for (int o = 0; o < CT; ++o) mu[o] = (red[o] + red[CT + o] + red[2 * CT + o] + red[3 * CT + o]) * (1.0f / 1024.0f);
    __syncthreads();
#pragma unroll
    for (int o = 0; o < CT; ++o) {
      const float a = res[o][0] - mu[o], b = res[o][1] - mu[o], c2 = res[o][2] - mu[o], d = res[o][3] - mu[o];
      const float s = wave_sum(a * a + b * b + c2 * c2 + d * d);
      if (lane == 0) red[w * CT + o] = s;
    }
    __syncthreads();
#pragma unroll
    for (int o = 0; o < CT; ++o) rs[o] = rsqrtf((red[o] + red[CT + o] + red[2 * CT + o] + red[3 * CT + o]) * (1.0f / 1024.0f) + LN_EPS);
    __syncthreads();
  }
  {
    const float4 gv = *(const float4*)(p.cln_g + c), bv = *(const float4*)(p.cln_b + c);
#pragma unroll
    for (int o = 0; o < CT; ++o) {
      float y0 = (res[o][0] - mu[o]) * rs[o] * gv.x + bv.x;
      float y1 = (res[o][1] - mu[o]) * rs[o] * gv.y + bv.y;
      float y2 = (res[o][2] - mu[o]) * rs[o] * gv.z + bv.z;
      float y3 = (res[o][3] - mu[o]) * rs[o] * gv.w + bv.w;
      y0 = y0 * sigmoidf_(y0); y1 = y1 * sigmoidf_(y1); y2 = y2 * sigmoidf_(y2); y3 = y3 * sigmoidf_(y3);
      *(uint2*)(p.MIXB + (size_t)(tok0 + o) * 2048 + 1024 + c) = make_uint2(pack2(y0, y1), pack2(y2, y3));
    }
  }
}

DI void qk4(const u16* __restrict__ Kb, int kstride, int key0, bf16x8 qf0, bf16x8 qf1, f32x4 (&s)[4], int l15, int quad) {
#pragma unroll
  for (int kt = 0; kt < 4; ++kt) {
    const u16* kr = Kb + (size_t)(key0 + kt * 16 + l15) * kstride + quad * 8;
    bf16x8 a0 = ld8(kr), a1 = ld8(kr + 32);
    f32x4 z = f32x4{0.f, 0.f, 0.f, 0.f};
    z = MFMA16(a0, qf0, z);
    z = MFMA16(a1, qf1, z);
    s[kt] = z;
  }
}
DI void qk4f(const u16* __restrict__ KCF, int c, bf16x8 qf0, bf16x8 qf1, f32x4 (&s)[4], int lane) {
#pragma unroll
  for (int kt = 0; kt < 4; ++kt) {
    const u16* kr = KCF + ((size_t)((c * 4 + kt) * 2) * 64 + lane) * 8;
    bf16x8 a0 = ld8(kr), a1 = ld8(kr + 512);
    f32x4 z = f32x4{0.f, 0.f, 0.f, 0.f};
    z = MFMA16(a0, qf0, z);
    z = MFMA16(a1, qf1, z);
    s[kt] = z;
  }
}
DI void pv4(const u16* __restrict__ Vt, int vstride, int key0, const f32x4 (&s)[4], f32x4 (&o)[4], int l15, int quad) {
#pragma unroll
  for (int ks2 = 0; ks2 < 2; ++ks2) {
    bf16x8 pb = packp(s[2 * ks2], s[2 * ks2 + 1]);
#pragma unroll
    for (int dt = 0; dt < 4; ++dt) {
      const u16* vr = Vt + (size_t)(dt * 16 + l15) * vstride + key0 + ks2 * 32 + quad * 4;
      uint2 lo = *(const uint2*)vr, hi = *(const uint2*)(vr + 16);
      o[dt] = MFMA16(comb(lo, hi), pb, o[dt]);
    }
  }
}
DI void pv4f(const u16* __restrict__ VCF, int c, const f32x4 (&s)[4], f32x4 (&o)[4], int lane) {
#pragma unroll
  for (int ks2 = 0; ks2 < 2; ++ks2) {
    bf16x8 pb = packp(s[2 * ks2], s[2 * ks2 + 1]);
#pragma unroll
    for (int dt = 0; dt < 4; ++dt)
      o[dt] = MFMA16(ld8(VCF + ((size_t)(((c * 2 + ks2) * 4 + dt) * 64) + lane) * 8), pb, o[dt]);
  }
}
DI void flash_block(const u16* __restrict__ Kb, const u16* __restrict__ Vt, int key0, int tq, float slope, bool rowok, int win,
                    bf16x8 qf0, bf16x8 qf1, float& m, float& l, f32x4 (&o)[4], int l15, int quad) {
  f32x4 s[4];
  qk4(Kb, HS, key0, qf0, qf1, s, l15, quad);
  float bm = -1e30f;
#pragma unroll
  for (int kt = 0; kt < 4; ++kt)
#pragma unroll
    for (int i = 0; i < 4; ++i) {
      int dist = tq - (key0 + kt * 16 + quad * 4 + i);
      bool valid = rowok && dist >= 0 && dist < win;
      float sv = valid ? (s[kt][i] * 0.125f - slope * (float)dist) : -1e30f;
      s[kt][i] = sv;
      bm = fmaxf(bm, sv);
    }
  bm = quad_maxf(bm);
  const float mn = fmaxf(m, bm);
  const float alpha = __expf(m - mn);
  float ps = 0.f;
#pragma unroll
  for (int kt = 0; kt < 4; ++kt)
#pragma unroll
    for (int i = 0; i < 4; ++i) {
      float sv = s[kt][i];
      float pv = (sv > -1e29f) ? __expf(sv - mn) : 0.f;
      s[kt][i] = pv;
      ps += pv;
    }
  ps = quad_sumf(ps);
  l = l * alpha + ps;
  m = mn;
#pragma unroll
  for (int dt = 0; dt < 4; ++dt) { o[dt][0] *= alpha; o[dt][1] *= alpha; o[dt][2] *= alpha; o[dt][3] *= alpha; }
  pv4(Vt, 4096, key0, s, o, l15, quad);
}

DI void nsa_item(const Params& p, int item, float* implds  , unsigned char* kvlds  ) {
  const int tid = threadIdx.x, lane = tid & 63, w = tid >> 6;
  const int l15 = lane & 15, quad = lane >> 4;
  int qt = item & 255; const int g = (item >> 8) & 3, b = item >> 10;
  const int t0 = qt * 16, tq = t0 + w * 4 + (l15 >> 2);
  const int hh = g * 4 + (l15 & 3);
  const float slope = exp2f(-0.5f * (float)(hh + 1));
  const size_t tokbase = (size_t)b * 4096;
  const u16* Hq = p.H + (tokbase + tq) * HS + hh * 64;
  const bf16x8 qf0 = ld8(Hq + quad * 8), qf1 = ld8(Hq + 32 + quad * 8);
  const u16* gp = p.H + (tokbase + tq) * HS + COL_GATE + hh * 3;
  const float g0 = sigmoidf_(bf2f(gp[0])), g1 = sigmoidf_(bf2f(gp[1])), g2 = sigmoidf_(bf2f(gp[2]));

  const u16* KCb = p.KC + ((size_t)(b * 4 + g) * 256) * 64;
  const u16* VCTb = p.VCT + ((size_t)(b * 4 + g) * 64) * 256;
  const int nmax = (t0 - 16) >> 4;
  const int nch = (nmax < 0) ? 0 : ((nmax >> 6) + 1);
  float mc = -1e30f, lc = 0.f;
#pragma unroll 1
  for (int c = 0; c < nch; ++c) {
    f32x4 s[4];
    qk4f(KCb, c, qf0, qf1, s, lane);
    float bm = -1e30f;
#pragma unroll
    for (int kt = 0; kt < 4; ++kt)
#pragma unroll
      for (int i = 0; i < 4; ++i) {
        int ce = 16 * (c * 64 + kt * 16 + quad * 4 + i) + 31;
        float sv = (ce <= tq) ? (s[kt][i] * 0.125f - slope * (float)(tq - ce)) : -1e30f;
        s[kt][i] = sv;
        bm = fmaxf(bm, sv);
      }
    bm = quad_maxf(bm);
    const float mn = fmaxf(mc, bm);
    float ps = 0.f;
#pragma unroll
    for (int kt = 0; kt < 4; ++kt)
#pragma unroll
      for (int i = 0; i < 4; ++i) ps += (s[kt][i] > -1e29f) ? __expf(s[kt][i] - mn) : 0.f;
    ps = quad_sumf(ps);
    lc = lc * __expf(mc - mn) + ps;
    mc = mn;
  }
  const float inv = lc > 0.f ? 1.0f / lc : 0.f;
  f32x4 oacc[4];
#pragma unroll
  for (int dt = 0; dt < 4; ++dt) oacc[dt] = f32x4{0.f, 0.f, 0.f, 0.f};
  {
    float* lastlds = (float*)kvlds;
#pragma unroll 1
    for (int c = 0; c < 4; ++c) {
      f32x4 s[4];
      if (c < nch) {
        qk4f(KCb, c, qf0, qf1, s, lane);
#pragma unroll
        for (int kt = 0; kt < 4; ++kt)
#pragma unroll
          for (int i = 0; i < 4; ++i) {
            int ce = 16 * (c * 64 + kt * 16 + quad * 4 + i) + 31;
            float sv = s[kt][i] * 0.125f - slope * (float)(tq - ce);
            s[kt][i] = (ce <= tq) ? __expf(sv - mc) * inv : 0.f;
          }
        pv4f(VCTb, c, s, oacc, lane);
      } else {
#pragma unroll
        for (int kt = 0; kt < 4; ++kt) s[kt] = f32x4{0.f, 0.f, 0.f, 0.f};
      }
#pragma unroll
      for (int kt = 0; kt < 4; ++kt) {
        implds[(w * 16 + c * 4 + kt) * 64 + lane] = s[kt][0] + s[kt][1] + s[kt][2] + s[kt][3];
        lastlds[(w * 16 + c * 4 + kt) * 64 + lane] = s[kt][3];
      }
    }
  }
#pragma unroll
  for (int dt = 0; dt < 4; ++dt) { oacc[dt][0] *= g0; oacc[dt][1] *= g0; oacc[dt][2] *= g0; oacc[dt][3] *= g0; }
  const int cur = tq >> 6;
  u64 sel = 0;
  {
    int v[16];
#pragma unroll
    for (int jj = 0; jj < 16; ++jj) {
      const int j = jj * 4 + quad;
      float a = implds[(w * 16 + jj) * 64 + lane];
      {
        const float* lastlds = (const float*)kvlds;
        const int pj = (quad > 0) ? jj : jj - 1;
        const int pl = (quad > 0) ? lane - 16 : lane + 48;
        const float nbv = lastlds[(w * 16 + (pj < 0 ? 0 : pj)) * 64 + pl];
        a += (pj < 0) ? 0.f : nbv;
      }
      a += dppf<0xB1>(a);
      a += dppf<0x4E>(a);
      const bool forced = (j == 0) || (j == cur) || (j == cur - 1);
      if (forced) a += 1.0e4f;
      if (j * 64 > tq) a = -1.0f;
      v[jj] = (__float_as_int(a) & ~63) | (63 - j);
    }
#pragma unroll 1
    for (int r = 0; r < 16; ++r) {
      int bv = v[0];
#pragma unroll
      for (int jj = 1; jj < 16; ++jj) bv = max(bv, v[jj]);
      bv = quad_maxi(bv);
      sel |= 1ull << (63 - (bv & 63));
#pragma unroll
      for (int jj = 0; jj < 16; ++jj) v[jj] = (v[jj] == bv) ? (int)0x80000000 : v[jj];
    }
    if (cur < 63) sel &= ((1ull << (cur + 1)) - 1ull);
  }
  u64 U, Uw;
  {
    unsigned lo = (unsigned)sel, hi = (unsigned)(sel >> 32);
    lo = row_or(lo); hi = row_or(hi);
    lo = __builtin_amdgcn_readfirstlane(lo); hi = __builtin_amdgcn_readfirstlane(hi);
    Uw = ((u64)hi << 32) | lo;
    unsigned* ux = (unsigned*)(kvlds + 2 * 64 * 72 * 2);
    if (lane == 0) { ux[w * 2] = lo; ux[w * 2 + 1] = hi; }
    __syncthreads();
    lo = ux[0] | ux[2] | ux[4] | ux[6]; hi = ux[1] | ux[3] | ux[5] | ux[7];
    lo = __builtin_amdgcn_readfirstlane(lo); hi = __builtin_amdgcn_readfirstlane(hi);
    U = ((u64)hi << 32) | lo;
  }
  {
    float ms = -1e30f, ls = 0.f, mw = -1e30f, lw = 0.f;
    f32x4 os[4], ow[4];
#pragma unroll
    for (int dt = 0; dt < 4; ++dt) { os[dt] = f32x4{0.f, 0.f, 0.f, 0.f}; ow[dt] = f32x4{0.f, 0.f, 0.f, 0.f}; }
    int jw = t0 - 511; if (jw < 0) jw = 0; jw >>= 6;
    const int jhi = (t0 + 15) >> 6;
    const int nsteps = __builtin_popcountll(U) + (jhi - jw + 1);
    const float SL2 = slope * 1.4426950408889634f, QS = 0.125f * 1.4426950408889634f;
    const float aq = -SL2 * (float)tq;
    float cE[4][4];
#pragma unroll
    for (int kt = 0; kt < 4; ++kt)
#pragma unroll
      for (int i = 0; i < 4; ++i) cE[kt][i] = SL2 * (float)(kt * 16 + quad * 4 + i);
    u16* tiles = (u16*)kvlds;
    const int srow = tid >> 3, scc = tid & 7;
    const u16* kbl = p.H + (tokbase + srow) * HS + COL_KV + 2 * 256 + g * 64 + scc * 8;
    const u16* vbl = p.VT + ((size_t)((0 * 2 + b) * 4 + g) * 64 + srow) * 4096 + scc * 8;
    uint4 rk0, rk1, rv0, rv1;
    int nkind, nj;
#define NSA_NEXT() do { if (U) { nkind = 0; nj = __builtin_ctzll(U); U &= U - 1; } else { nkind = 1; nj = jw++; } } while (0)
#define NSA_FETCH() do { const u16* kb_ = kbl + (size_t)(nj * 64) * HS + nkind * 512; \
      const u16* vb_ = vbl + (size_t)nkind * (2 * 4 * 64 * 4096) + nj * 64; \
      rk0 = *(const uint4*)kb_; rk1 = *(const uint4*)(kb_ + (size_t)32 * HS); \
      rv0 = *(const uint4*)vb_; rv1 = *(const uint4*)(vb_ + (size_t)32 * 4096); } while (0)
    NSA_NEXT();
    NSA_FETCH();
#pragma unroll 1
    for (int st = 0; st < nsteps; ++st) {
      u16* sK = tiles + (st & 1) * (2 * 64 * 72);
      u16* sV = sK + 64 * 72;
      *(uint4*)(sK + srow * 72 + scc * 8) = rk0; *(uint4*)(sK + (srow + 32) * 72 + scc * 8) = rk1;
      *(uint4*)(sV + srow * 72 + scc * 8) = rv0; *(uint4*)(sV + (srow + 32) * 72 + scc * 8) = rv1;
      const int ckind = nkind, cj = nj;
      __syncthreads();
      if (st + 1 < nsteps) { NSA_NEXT(); NSA_FETCH(); }
      if (ckind || ((Uw >> cj) & 1ull)) {
      const int key0 = cj * 64;
      f32x4 s[4];
#pragma unroll
      for (int kt = 0; kt < 4; ++kt) {
        const u16* kr = sK + (kt * 16 + l15) * 72 + quad * 8;
        bf16x8 a0 = *(const bf16x8*)kr, a1 = *(const bf16x8*)(kr + 32);
        f32x4 z = f32x4{0.f, 0.f, 0.f, 0.f};
        z = MFMA16(a0, qf0, z);
        z = MFMA16(a1, qf1, z);
        s[kt] = z;
      }
      const float mold = ckind ? mw : ms;
      const float base = aq + SL2 * (float)key0;
      const int thr2 = tq - key0 - quad * 4;
      float bm = -1e30f;
      if (ckind) {
        const int thr3 = thr2 - 512;
#pragma unroll
        for (int kt = 0; kt < 4; ++kt)
#pragma unroll
          for (int i = 0; i < 4; ++i) {
            const float x = fmaf(s[kt][i], QS, base + cE[kt][i]);
            const bool valid = (kt * 16 + i <= thr2) && (kt * 16 + i > thr3);
            const float sv = valid ? x : -1e30f;
            s[kt][i] = sv;
            bm = fmaxf(bm, sv);
          }
      } else {
        const bool rowok = (bool)((sel >> cj) & 1ull);
#pragma unroll
        for (int kt = 0; kt < 4; ++kt)
#pragma unroll
          for (int i = 0; i < 4; ++i) {
            const float x = fmaf(s[kt][i], QS, base + cE[kt][i]);
            const bool valid = rowok && (kt * 16 + i <= thr2);
            const float sv = valid ? x : -1e30f;
            s[kt][i] = sv;
            bm = fmaxf(bm, sv);
          }
      }
      bm = quad_maxf(bm);
      const float mn = fmaxf(mold, bm);
      const float alpha = __builtin_amdgcn_exp2f(mold - mn);
      const float mne = fmaxf(mn, -1e20f);
      float ps = 0.f;
#pragma unroll
      for (int kt = 0; kt < 4; ++kt)
#pragma unroll
        for (int i = 0; i < 4; ++i) {
          const float pv = __builtin_amdgcn_exp2f(s[kt][i] - mne);
          s[kt][i] = pv;
          ps += pv;
        }
      ps = quad_sumf(ps);
      bf16x8 pb0 = packp(s[0], s[1]), pb1 = packp(s[2], s[3]);
      if (ckind) {
        lw = lw * alpha + ps; mw = mn;
#pragma unroll
        for (int dt = 0; dt < 4; ++dt) {
          ow[dt][0] *= alpha; ow[dt][1] *= alpha; ow[dt][2] *= alpha; ow[dt][3] *= alpha;
          const u16* vr = sV + (dt * 16 + l15) * 72 + quad * 4;
          ow[dt] = MFMA16(comb(*(const uint2*)vr, *(const uint2*)(vr + 16)), pb0, ow[dt]);
          ow[dt] = MFMA16(comb(*(const uint2*)(vr + 32), *(const uint2*)(vr + 48)), pb1, ow[dt]);
        }
      } else {
        ls = ls * alpha + ps; ms = mn;
#pragma unroll
        for (int dt = 0; dt < 4; ++dt) {
          os[dt][0] *= alpha; os[dt][1] *= alpha; os[dt][2] *= alpha; os[dt][3] *= alpha;
          const u16* vr = sV + (dt * 16 + l15) * 72 + quad * 4;
          os[dt] = MFMA16(comb(*(const uint2*)vr, *(const uint2*)(vr + 16)), pb0, os[dt]);
          os[dt] = MFMA16(comb(*(const uint2*)(vr + 32), *(const uint2*)(vr + 48)), pb1, os[dt]);
        }
      }
      }
    }
#undef NSA_NEXT
#undef NSA_FETCH
    __syncthreads();
    const float scs = g1 / ls, scw = g2 / lw;
#pragma unroll
    for (int dt = 0; dt < 4; ++dt) {
      oacc[dt][0] += scs * os[dt][0] + scw * ow[dt][0]; oacc[dt][1] += scs * os[dt][1] + scw * ow[dt][1];
      oacc[dt][2] += scs * os[dt][2] + scw * ow[dt][2]; oacc[dt][3] += scs * os[dt][3] + scw * ow[dt][3];
    }
  }
  u16* op = p.MIXB + (tokbase + tq) * 2048 + hh * 64 + quad * 4;
#pragma unroll
  for (int dt = 0; dt < 4; ++dt)
    *(uint2*)(op + dt * 16) = make_uint2(pack2(oacc[dt][0], oacc[dt][1]), pack2(oacc[dt][2], oacc[dt][3]));
}

DI void ln1_item(const Params& p, int item) {
  const int lane = threadIdx.x & 63, w = threadIdx.x >> 6;
  const int row = item * 4 + w;
  float* yr = p.Y + (size_t)row * 2048;
  float4 v[8];
  float s = 0.f;
#pragma unroll
  for (int i = 0; i < 8; ++i) { v[i] = *(const float4*)(yr + (lane + 64 * i) * 4); s += v[i].x + v[i].y + v[i].z + v[i].w; }
  const float mu = wave_sum(s) * (1.0f / 2048.0f);
  float q = 0.f;
#pragma unroll
  for (int i = 0; i < 8; ++i) { float a = v[i].x - mu, b = v[i].y - mu, c = v[i].z - mu, d = v[i].w - mu; q += a * a + b * b + c * c + d * d; }
  const float rs = rsqrtf(wave_sum(q) * (1.0f / 2048.0f) + LN_EPS);
#pragma unroll
  for (int i = 0; i < 8; ++i) {
    int c = (lane + 64 * i) * 4;
    float4 gv = *(const float4*)(p.ln1_g + c), bv = *(const float4*)(p.ln1_b + c);
    float4 o = make_float4((v[i].x - mu) * rs * gv.x + bv.x, (v[i].y - mu) * rs * gv.y + bv.y, (v[i].z - mu) * rs * gv.z + bv.z, (v[i].w - mu) * rs * gv.w + bv.w);
    *(float4*)(yr + c) = o;
    *(uint2*)(p.YB + (size_t)row * 2048 + c) = make_uint2(pack2(o.x, o.y), pack2(o.z, o.w));
  }
}

DI void peer_select_item(const Params& p, int item, float* lds) {
  const int lane = threadIdx.x & 63, w = threadIdx.x >> 6;
  const int l15 = lane & 15, quad = lane >> 4;
  const int tile = item >> 1, h = (item & 1) * 4 + w;
  const int tok = tile * 16 + l15;
  const u16* qfr = p.PQ + (((size_t)tile * 16 + h * 2) * 4 * 64 + lane) * 8;
  float* lv = lds + w * 1536;
  int* li = (int*)(lv + 512);
  float* tvl = lv + 1024;
  int* el = (int*)(lv + 1280);
#pragma unroll 1
  for (int c = 0; c < 2; ++c) {
    bf16x8 bq[4];
#pragma unroll
    for (int ks = 0; ks < 4; ++ks) bq[ks] = ld8(qfr + (size_t)((c * 4 + ks) * 64) * 8);
    const u16* kb = p.PKEYS + ((size_t)(h * 2 + c) * 2048 + lane) * 8;
    int a[32];
#pragma unroll
    for (int kt = 0; kt < 8; ++kt) {
      f32x4 z = f32x4{0.f, 0.f, 0.f, 0.f};
#pragma unroll
      for (int ks = 0; ks < 4; ++ks) z = MFMA16(ld8(kb + (size_t)(kt * 4 + ks) * 512), bq[ks], z);
#pragma unroll
      for (int i = 0; i < 4; ++i) {
        const int b = __float_as_int(z[i]);
        const int k = b ^ ((b >> 31) & 0x7fffffff);
        a[kt * 4 + i] = (k & ~127) | (127 - (kt * 16 + quad * 4 + i));
      }
    }
#pragma unroll
    for (int k = 2; k <= 32; k <<= 1) {
#pragma unroll
      for (int j = k >> 1; j > 0; j >>= 1) {
#pragma unroll
        for (int i = 0; i < 32; ++i) {
          const int l = i ^ j;
          if (l > i) {
            const bool desc = ((i & k) == 0);
            const int hi = max(a[i], a[l]), lo = min(a[i], a[l]);
            a[i] = desc ? hi : lo; a[l] = desc ? lo : hi;
          }
        }
      }
    }
#pragma unroll 1
    for (int r = 0; r < 16; ++r) {
      const int bk = quad_maxi(a[0]);
      if (quad == 0) {
        const int kv = bk & ~127;
        lv[(c * 16 + r) * 16 + l15] = __int_as_float(kv ^ ((kv >> 31) & 0x7fffffff));
        li[(c * 16 + r) * 16 + l15] = 127 - (bk & 127);
      }
      const bool win = (a[0] == bk);
#pragma unroll
      for (int i = 0; i < 15; ++i) a[i] = win ? a[i + 1] : a[i];
      a[15] = win ? (int)0x80000000 : a[15];
    }
  }
  __syncthreads();
  float cv[13]; int cf[13];
#pragma unroll
  for (int k = 0; k < 13; ++k) {
    int a, bb; bool ok = true;
    if (k < 4) { a = 0; bb = k * 4 + quad; }
    else if (k < 6) { a = 1; bb = (k - 4) * 4 + quad; }
    else if (k == 6) { a = 2; bb = quad; }
    else if (k == 7) { a = 3; bb = quad; }
    else if (k == 8) { a = 8 + quad; bb = 0; }
    else if (k == 9) { a = 12 + quad; bb = 0; }
    else if (k == 10) { a = 4 + quad; bb = 0; }
    else if (k == 11) { a = 4 + quad; bb = 1; }
    else { a = (quad == 0) ? 2 : 4; bb = (quad == 0) ? 4 : 2; ok = quad < 2; }
    float v = lv[(0 * 16 + a) * 16 + l15] + lv[(1 * 16 + bb) * 16 + l15];
    cv[k] = ok ? v : -3.0e38f;
    cf[k] = ok ? (a * 16 + bb) : 999;
  }
  float tmax = 0.f, sum = 0.f;
#pragma unroll 1
  for (int r = 0; r < 16; ++r) {
    float bv = cv[0];
#pragma unroll
    for (int k = 1; k < 13; ++k) bv = fmaxf(bv, cv[k]);
    bv = quad_maxf(bv);
    int bi = 1000;
#pragma unroll
    for (int k = 0; k < 13; ++k) bi = (cv[k] == bv) ? min(bi, cf[k]) : bi;
    bi = quad_mini(bi);
    if (r == 0) tmax = bv;
    const float e = __expf(bv - tmax);
    sum += e;
    if (quad == 0) {
      const int a = bi >> 4, bb = bi & 15;
      el[r * 16 + l15] = li[(0 * 16 + a) * 16 + l15] * 128 + li[(1 * 16 + bb) * 16 + l15];
      tvl[r * 16 + l15] = e;
    }
#pragma unroll
    for (int k = 0; k < 13; ++k) cv[k] = (cf[k] == bi) ? -3.0e38f : cv[k];
  }
  __syncthreads();
  {
    const float isum = 1.0f / sum;
    int* ep = p.EIDX + (size_t)tok * 128 + h * 16 + quad * 4;
    float* gw = p.GW + (size_t)tok * 128 + h * 16 + quad * 4;
    const int r0 = quad * 4;
    *(int4*)ep = make_int4(el[(r0 + 0) * 16 + l15], el[(r0 + 1) * 16 + l15], el[(r0 + 2) * 16 + l15], el[(r0 + 3) * 16 + l15]);
    *(float4*)gw = make_float4(tvl[(r0 + 0) * 16 + l15] * isum, tvl[(r0 + 1) * 16 + l15] * isum, tvl[(r0 + 2) * 16 + l15] * isum, tvl[(r0 + 3) * 16 + l15] * isum);
  }
  __syncthreads();
}

#ifndef GB
#define GB 16
#endif
DI void peer_gather_item(const Params& p, int item, float* lds  ) {
  const int tid = threadIdx.x, lane = tid & 63, w = tid >> 6;
  const int tok = item * 4 + w;
  float* coef = lds + w * 128;
  int* idl = (int*)(lds + 512) + w * 128;
  const float* yrow = p.Y + (size_t)tok * 2048 + lane * 32;
  const int* eix = p.EIDX + (size_t)tok * 128;
  const float* gwp = p.GW + (size_t)tok * 128;
  const unsigned char* UBq = (const unsigned char*)p.UB;
  const unsigned char* VBq = (const unsigned char*)p.VB;
  idl[lane] = p.EIDX[(size_t)tok * 128 + lane]; idl[64 + lane] = p.EIDX[(size_t)tok * 128 + 64 + lane];
  float y[32];
#pragma unroll
  for (int j = 0; j < 8; ++j) {
    float4 a = *(const float4*)(yrow + j * 4);
    y[j * 4 + 0] = a.x; y[j * 4 + 1] = a.y; y[j * 4 + 2] = a.z; y[j * 4 + 3] = a.w;
  }
#pragma unroll 1
  for (int e8 = 0; e8 < 128; e8 += GB) {
    uint4 ra[GB]; uint2 rb[GB];
    int idx[GB];
#pragma unroll
    for (int u = 0; u < GB; ++u) {
      idx[u] = __builtin_amdgcn_readfirstlane(idl[e8 + u]);
      const unsigned char* up = UBq + (size_t)idx[u] * ROWB;
      ra[u] = *(const uint4*)(up + lane * 16);
      rb[u] = *(const uint2*)(up + 1024 + lane * 8);
    }
#pragma unroll
    for (int u = 0; u < GB; ++u) {
      const v6u q = {ra[u].x, ra[u].y, ra[u].z, ra[u].w, rb[u].x, rb[u].y};
      const v32f dv = __builtin_amdgcn_cvt_scalef32_pk32_f32_fp6(q, 1.0f);
      float d0 = 0.f, d1 = 0.f, d2 = 0.f, d3 = 0.f;
#pragma unroll
      for (int k = 0; k < 32; k += 4) { d0 += y[k] * dv[k]; d1 += y[k + 1] * dv[k + 1]; d2 += y[k + 2] * dv[k + 2]; d3 += y[k + 3] * dv[k + 3]; }
      float d = wave_sum((d0 + d1) + (d2 + d3)) * p.USC[idx[u]];
      if (lane == 0) coef[e8 + u] = gelu_tanh(d) * gwp[e8 + u] * p.VSC[idx[u]];
    }
  }
  float acc[32];
#pragma unroll
  for (int i = 0; i < 32; ++i) acc[i] = DN_ALPHA * y[i];
#pragma unroll 1
  for (int e8 = 0; e8 < 128; e8 += GB) {
    uint4 ra[GB]; uint2 rb[GB];
    float cf[GB];
#pragma unroll
    for (int u = 0; u < GB; ++u) {
      const int idx = __builtin_amdgcn_readfirstlane(idl[e8 + u]);
      cf[u] = coef[e8 + u];
      const unsigned char* vp = VBq + (size_t)idx * ROWB;
      ra[u] = *(const uint4*)(vp + lane * 16);
      rb[u] = *(const uint2*)(vp + 1024 + lane * 8);
    }
#pragma unroll
    for (int u = 0; u < GB; ++u) {
      const v6u q = {ra[u].x, ra[u].y, ra[u].z, ra[u].w, rb[u].x, rb[u].y};
      const v32f dv = __builtin_amdgcn_cvt_scalef32_pk32_f32_fp6(q, 1.0f);
#pragma unroll
      for (int k = 0; k < 32; ++k) acc[k] += cf[u] * dv[k];
    }
  }
  float s = 0.f;
#pragma unroll
  for (int i = 0; i < 32; ++i) s += acc[i];
  const float mu = wave_sum(s) * (1.0f / 2048.0f);
  float qv = 0.f;
#pragma unroll
  for (int i = 0; i < 32; ++i) { float d = acc[i] - mu; qv += d * d; }
  const float rs = rsqrtf(wave_sum(qv) * (1.0f / 2048.0f) + LN_EPS);
  float* op = p.out + (size_t)tok * 2048 + lane * 32;
#pragma unroll
  for (int j = 0; j < 8; ++j) {
    const float4 gv = *(const float4*)(p.ln2_g + lane * 32 + j * 4), bv = *(const float4*)(p.ln2_b + lane * 32 + j * 4);
    *(float4*)(op + j * 4) = make_float4((acc[j * 4 + 0] - mu) * rs * gv.x + bv.x, (acc[j * 4 + 1] - mu) * rs * gv.y + bv.y,
                                         (acc[j * 4 + 2] - mu) * rs * gv.z + bv.z, (acc[j * 4 + 3] - mu) * rs * gv.w + bv.w);
  }
}

constexpr int LDS_BYTES = 65536;
__global__ void __launch_bounds__(256, 2) mega(Params p) {
  __shared__ __attribute__((aligned(16))) unsigned char smem[LDS_BYTES];
  __shared__ uint4 xb_words;
  const int lo = (int)p.phase_lo, hi = (int)p.phase_hi;
  if (threadIdx.x == 0) xb_words = make_uint4(0u, 0u, 0u, 0u);
  __syncthreads();
  volatile LAS unsigned* const xst = (volatile LAS unsigned*)&xb_words;
  if (threadIdx.x == 0) (void)xb_add(&p.BAR[XB_XCNT(xb_xcc_id())], 1u);
  if (lo > 1000) cg::this_grid().sync();
#ifdef ONLY_PHASE
#define PH_ON(n) ((n) == ONLY_PHASE)
#else
#define PH_ON(n) true
#endif
#ifndef REP_MASK
#define REP_MASK 0
#endif
#define PH_BEGIN(n) if (PH_ON(n) && lo <= (n) && (n) < hi) { if ((n) > lo) xcd_barrier(p.BAR, xst); for (int rep_ = 0; rep_ < 1 + ((REP_MASK >> (n)) & 1); ++rep_) {
#define PH_END } }
  PH_BEGIN(0) phase_prep(p, (float*)smem); PH_END
  PH_BEGIN(1) phase_gemm1(p, (u16*)smem, xst); PH_END
  PH_BEGIN(2)
    for (int it = blockIdx.x; it < 128; it += gridDim.x) compress_item(p, it, (u16*)smem);
    for (;;) {
      if (threadIdx.x == 0) xst[2] = xb_add(&p.BAR[2], 1u);
      __syncthreads();
      const int k = (int)xst[2];
      __syncthreads();
      if (k >= NTOK / CT) break;
      conv_item(p, k, (float*)smem);
    }
  PH_END
  PH_BEGIN(3)
    if (blockIdx.x % 5 == 0) {
      const int nq = (gridDim.x + 4) / 5;
      for (int c = blockIdx.x / 5; c < 512; c += nq) {
        if (c < 256) quant_rows_fp6(p.pu, (unsigned char*)p.UB, p.USC, c * 64, 64);
        else         quant_rows_fp6(p.pv, (unsigned char*)p.VB, p.VSC, (c - 256) * 64, 64);
      }
      transpose_cvt(p.w_out, 2048, 2048, p.WOUTT, 2048, (float*)smem, blockIdx.x / 5, nq);
      transpose_cvt(p.wq, 2048, 2048, p.WQT, 2048, (float*)smem, blockIdx.x / 5, nq);
    }
    for (;;) {
      if (threadIdx.x == 0) xst[2] = xb_add(&p.BAR[1], 1u);
      __syncthreads();
      const int k = (int)xst[2];
      __syncthreads();
      if (k >= 2048) break;
      nsa_item(p, ((k & 7) << 8) | (255 - (k >> 3)), (float*)smem, smem + 16384);
    }
  PH_END
  PH_BEGIN(4) phase_gemm_mix(p, (u16*)smem); PH_END
  PH_BEGIN(5)
    for (int it = blockIdx.x; it < 2048; it += gridDim.x) ln1_item(p, it);
  PH_END
  PH_BEGIN(6) phase_gemm_pq(p, (u16*)smem); PH_END
  PH_BEGIN(7)
    for (int it = blockIdx.x; it < 1024; it += gridDim.x) peer_select_item(p, it, (float*)smem);
  PH_END
  PH_BEGIN(8)
    for (int it = blockIdx.x; it < NTOK / 4; it += gridDim.x) peer_gather_item(p, it, (float*)smem);
  PH_END
}

extern "C" void kernel_launch(void* const* d_in, const int* in_sizes, int n_in, void* d_out, int out_size,
                              void* d_ws, size_t ws_size, hipStream_t stream) {
  Params p{};
  const float** f = (const float**)&p;
  for (int i = 0; i < 21; ++i) f[i] = (const float*)d_in[i];
  p.out = (float*)d_out;
  unsigned char* ws = (unsigned char*)d_ws;
  size_t off = 0;
  auto take = [&](size_t bytes) { unsigned char* r = ws + off; off += (bytes + 255) & ~(size_t)255; return r; };
  p.XB = (u16*)take((size_t)NTOK * 2048 * 2);
  p.WINT = (u16*)take((size_t)HS * 2048 * 2);
  p.WOUTT = (u16*)take((size_t)2048 * 2048 * 2);
  p.WQT = (u16*)take((size_t)2048 * 2048 * 2);
  p.W1KT = (u16*)take((size_t)256 * 2048 * 2);
  p.W1VT = (u16*)take((size_t)256 * 2048 * 2);
  p.W2KT = (u16*)take((size_t)64 * 256 * 2);
  p.W2VT = (u16*)take((size_t)64 * 256 * 2);
  p.PKEYS = (u16*)take((size_t)8 * 2 * 128 * 128 * 2);
  p.UB = (u16*)take((size_t)16384 * ROWB);
  p.VB = (u16*)take((size_t)16384 * ROWB);
  p.USC = (float*)take(16384 * 4);
  p.VSC = (float*)take(16384 * 4);
  p.H = (u16*)take((size_t)NTOK * HS * 2);
  p.VT = (u16*)take((size_t)2 * 2 * 4 * 64 * 4096 * 2);
  p.KC = (u16*)take((size_t)8 * 256 * 64 * 2);
  p.VCT = (u16*)take((size_t)8 * 64 * 256 * 2);
  p.MIXB = (u16*)take((size_t)NTOK * 2048 * 2);
  p.BIAS = (float*)take(512 * 4);
  p.Y = (float*)take((size_t)NTOK * 2048 * 4);
  p.GW = (float*)take((size_t)NTOK * 128 * 4);
  p.EIDX = (int*)take((size_t)NTOK * 128 * 4);
  p.BAR = (unsigned*)take(XCD_BAR_WORDS * 4);
  p.YB = p.XB;
  p.PQ = p.MIXB;
  if (off > ws_size) { fprintf(stderr, "kernel_launch: workspace too small (%zu > %zu)\n", off, ws_size); return; }

  static int grid_blocks = 0;
  if (!grid_blocks) {
    int dev = 0, cus = 0, per_cu = 0;
    hipGetDevice(&dev);
    hipDeviceGetAttribute(&cus, hipDeviceAttributeMultiprocessorCount, dev);
    hipOccupancyMaxActiveBlocksPerMultiprocessor(&per_cu, mega, 256, 0);
    if (per_cu < 1) per_cu = 1;
    grid_blocks = cus * per_cu;
  }
  (void)hipMemsetAsync(p.BAR, 0, XCD_BAR_WORDS * 4, stream);
#if N_LAUNCH_MODE == 1
  p.phase_lo = 0; p.phase_hi = NPHASE;
  void* args[] = {&p};
  hipError_t e = hipLaunchCooperativeKernel((void*)mega, dim3(grid_blocks), dim3(256), args, 0, stream);
  if (e != hipSuccess) fprintf(stderr, "cooperative launch failed: %s (grid %d)\n", hipGetErrorString(e), grid_blocks);
#else
  for (int ph = 0; ph < NPHASE; ++ph) {
    p.phase_lo = ph; p.phase_hi = ph + 1;
    hipLaunchKernelGGL(mega, dim3(grid_blocks), dim3(256), 0, stream, p);
  }
#endif
}
```

```cpp
#include <hip/hip_runtime.h>
#include <hip/hip_cooperative_groups.h>
#include <cstdio>
namespace cg = cooperative_groups;

typedef unsigned short u16;
typedef unsigned long long u64;
using bf16x8 = __attribute__((ext_vector_type(8))) short;
using f32x4  = __attribute__((ext_vector_type(4))) float;
#define DI __device__ __forceinline__
#define MFMA16(a, b, c) __builtin_amdgcn_mfma_f32_16x16x32_bf16((a), (b), (c), 0, 0, 0)

#ifndef N_LAUNCH_MODE
#define N_LAUNCH_MODE 1
#endif

constexpr int D_MODEL = 2048, SEQ = 4096, NTOK = 8192;
constexpr int D_IN = 4656, HS = 4736;
constexpr int COL_KV = 1024, COL_GATE = 2560, COL_CONV = 2608;
constexpr float DN_ALPHA = 1.189207115002721f;
constexpr float LN_EPS = 1e-5f;
constexpr int NPHASE = 9;

struct Params {
  const float *x, *w_in, *pos_k, *w1_k, *w2_k, *pos_v, *w1_v, *w2_v, *dw_w, *dw_b, *cln_g, *cln_b,
      *w_out, *ln1_g, *ln1_b, *wq, *pkeys, *pu, *pv, *ln2_g, *ln2_b;
  float* out;
  u16 *XB, *WINT, *WOUTT, *WQT, *W1KT, *W1VT, *W2KT, *W2VT, *PKEYS, *UB, *VB, *H, *VT, *KC, *VCT, *MIXB, *YB, *PQ;
  float *BIAS, *Y, *GW, *USC, *VSC;
  int* EIDX;
  unsigned* BAR;
  long long phase_lo, phase_hi;
};

typedef __bf16 bf16x2_hw __attribute__((ext_vector_type(2)));
typedef float f32x2_hw __attribute__((ext_vector_type(2)));
DI unsigned pack2(float lo, float hi) {
  const f32x2_hw v = {lo, hi};
  return __builtin_bit_cast(unsigned, __builtin_convertvector(v, bf16x2_hw));
}
DI u16 f2bf(float x) { return (u16)(pack2(x, 0.f) & 0xffffu); }
DI float bf2f(u16 b) { return __uint_as_float(((unsigned)b) << 16); }
DI float bflo(unsigned u) { return __uint_as_float(u << 16); }
DI float bfhi(unsigned u) { return __uint_as_float(u & 0xffff0000u); }
DI float sigmoidf_(float x) { return __builtin_amdgcn_rcpf(1.0f + __expf(-x)); }
DI float gelu_tanh(float x) {
  float z = 0.7978845608028654f * (x + 0.044715f * x * x * x);
  float t = 1.0f - 2.0f * __builtin_amdgcn_rcpf(__expf(2.0f * z) + 1.0f);
  return 0.5f * x * (1.0f + t);
}
DI float q16f(float v, bool sum) {
  auto r = __builtin_amdgcn_permlane16_swap(__float_as_uint(v), __float_as_uint(v), false, false);
  const float a = __uint_as_float(r[0]), b = __uint_as_float(r[1]);
  return sum ? a + b : fmaxf(a, b);
}
DI float q32f(float v, bool sum) {
  auto r = __builtin_amdgcn_permlane32_swap(__float_as_uint(v), __float_as_uint(v), false, false);
  const float a = __uint_as_float(r[0]), b = __uint_as_float(r[1]);
  return sum ? a + b : fmaxf(a, b);
}
DI float quad_maxf(float v) { return q32f(q16f(v, false), false); }
DI float quad_sumf(float v) { return q32f(q16f(v, true), true); }
DI int quad_maxi(int v) {
  auto r = __builtin_amdgcn_permlane16_swap((unsigned)v, (unsigned)v, false, false);
  v = max((int)r[0], (int)r[1]);
  auto s = __builtin_amdgcn_permlane32_swap((unsigned)v, (unsigned)v, false, false);
  return max((int)s[0], (int)s[1]);
}
DI int quad_mini(int v) {
  auto r = __builtin_amdgcn_permlane16_swap((unsigned)v, (unsigned)v, false, false);
  v = min((int)r[0], (int)r[1]);
  auto s = __builtin_amdgcn_permlane32_swap((unsigned)v, (unsigned)v, false, false);
  return min((int)s[0], (int)s[1]);
}
template <int CTRL> DI float dppf(float v) { return __int_as_float(__builtin_amdgcn_update_dpp(0, __float_as_int(v), CTRL, 0xf, 0xf, false)); }
DI float wave_sum(float v) {
  v += dppf<0xB1>(v);
  v += dppf<0x4E>(v);
  v += dppf<0x141>(v);
  v += dppf<0x140>(v);
  return quad_sumf(v);
}
template <int CTRL> DI unsigned dppu(unsigned v) { return (unsigned)__builtin_amdgcn_update_dpp(0, (int)v, CTRL, 0xf, 0xf, false); }
DI float wave_max(float v) {
  v = fmaxf(v, dppf<0xB1>(v)); v = fmaxf(v, dppf<0x4E>(v)); v = fmaxf(v, dppf<0x141>(v)); v = fmaxf(v, dppf<0x140>(v));
  return quad_maxf(v);
}
DI unsigned row_or(unsigned v) {
  v |= dppu<0xB1>(v); v |= dppu<0x4E>(v); v |= dppu<0x141>(v); v |= dppu<0x140>(v);
  return v;
}
DI float block_sum(float v, float* red) {
  v = wave_sum(v);
  if ((threadIdx.x & 63) == 0) red[threadIdx.x >> 6] = v;
  __syncthreads();
  float r = red[0] + red[1] + red[2] + red[3];
  __syncthreads();
  return r;
}
DI bf16x8 ld8(const u16* p) { return *(const bf16x8*)p; }
DI bf16x8 comb(uint2 lo, uint2 hi) {
  uint4 v = make_uint4(lo.x, lo.y, hi.x, hi.y);
  return __builtin_bit_cast(bf16x8, v);
}
DI bf16x8 packp(f32x4 a, f32x4 b) {
  uint4 v = make_uint4(pack2(a[0], a[1]), pack2(a[2], a[3]), pack2(b[0], b[1]), pack2(b[2], b[3]));
  return __builtin_bit_cast(bf16x8, v);
}

#define XB_TMO      128
#define XB_XCNT(j)  (256  + 64 * (j))
#define XB_XSUB(j)  (1280 + 64 * (j))
#define XB_XGEN(j)  (2304 + 64 * (j))
#define XB_TOP      3328
#define XB_TOPGEN   3392
#define XCD_BAR_WORDS 3456
#define XB_SPIN_CAP (1u << 22)
#define LAS __attribute__((address_space(3)))
DI unsigned xb_ld(unsigned* p)              { return __hip_atomic_load(p, __ATOMIC_RELAXED, __HIP_MEMORY_SCOPE_AGENT); }
DI unsigned xb_add(unsigned* p, unsigned v) { return __hip_atomic_fetch_add(p, v, __ATOMIC_RELAXED, __HIP_MEMORY_SCOPE_AGENT); }
DI unsigned xb_xcc_id() { return (unsigned)__builtin_amdgcn_s_getreg((3 << 11) | 20) & 0xFu; }
#define XB_SPIN(cond, bar) do { unsigned _sp = 0; while (cond) { __builtin_amdgcn_s_sleep(1); \
    if ((++_sp & 255u) == 0u) { if (xb_ld(&(bar)[XB_TMO])) break; if (_sp > XB_SPIN_CAP) { (void)xb_add(&(bar)[XB_TMO], 1u); break; } } } } while (0)
struct XcdBarrier { unsigned* bar; unsigned x; volatile LAS unsigned* st; };
DI XcdBarrier xcd_barrier_post(unsigned* bar, volatile LAS unsigned* st) {
  XcdBarrier b; b.bar = bar; b.x = xb_xcc_id(); b.st = st;
  if (threadIdx.x == 0) (void)xb_add(&bar[XB_XCNT(b.x)], 1u);
  return b;
}
DI void xcd_barrier_complete(unsigned* bar, unsigned x, unsigned& nloc, unsigned& nx) {
  const unsigned G = gridDim.x * gridDim.y * gridDim.z;
  unsigned sum, cnt, mine, sp = 0u;
  for (;;) {
    sum = 0u; cnt = 0u; mine = 0u;
#pragma unroll 1
    for (unsigned j = 0; j < 16; ++j) { const unsigned c = xb_ld(&bar[XB_XCNT(j)]); sum += c; cnt += (c > 0u) ? 1u : 0u; mine = (j == x) ? c : mine; }
    if (sum == G) break;
    __builtin_amdgcn_s_sleep(1);
    if ((++sp & 255u) == 0u) { if (xb_ld(&bar[XB_TMO])) break; if (sp > XB_SPIN_CAP) { (void)xb_add(&bar[XB_TMO], 1u); break; } }
  }
  nloc = mine > 0u ? mine : 1u; nx = cnt > 0u ? cnt : 1u;
}
DI void xcd_barrier(unsigned* const bar, volatile LAS unsigned* const bst) {
  const unsigned bx = xb_xcc_id();
  asm volatile("s_waitcnt vmcnt(0)" ::: "memory");
  __syncthreads();
  if (threadIdx.x == 0) {
    __builtin_amdgcn_s_waitcnt(0);
    unsigned nloc = bst[0], nx = bst[1];
    if (nloc == 0u) { xcd_barrier_complete(bar, bx, nloc, nx); bst[0] = nloc; bst[1] = nx; }
    const unsigned old = xb_add(&bar[XB_XSUB(bx)], 1u);
    const unsigned gen = old / nloc;
    if (old + 1u == (gen + 1u) * nloc) {
      __builtin_amdgcn_fence(__ATOMIC_RELEASE, "agent");
      asm volatile("s_waitcnt vmcnt(0)" ::: "memory");
      const unsigned og = xb_add(&bar[XB_TOP], 1u);
      const unsigned tg = og / nx;
      if (og + 1u == (tg + 1u) * nx) xb_add(&bar[XB_TOPGEN], 1u);
      else XB_SPIN(xb_ld(&bar[XB_TOPGEN]) == tg, bar);
      __builtin_amdgcn_fence(__ATOMIC_ACQUIRE, "agent");
      xb_add(&bar[XB_XGEN(bx)], 1u);
      asm volatile("s_waitcnt vmcnt(0)" ::: "memory");
    } else {
      XB_SPIN(xb_ld(&bar[XB_XGEN(bx)]) == gen, bar);
      __builtin_amdgcn_fence(__ATOMIC_ACQUIRE, "agent");
      asm volatile("s_waitcnt vmcnt(0)" ::: "memory");
    }
  }
  __syncthreads();
}

DI void cvt_f32_bf16(const float* __restrict__ src, u16* __restrict__ dst, size_t n8) {
  size_t i = (size_t)blockIdx.x * 256 + threadIdx.x, stride = (size_t)gridDim.x * 256;
  for (; i < n8; i += stride) {
    float4 a = ((const float4*)src)[2 * i], b = ((const float4*)src)[2 * i + 1];
    uint4 o = make_uint4(pack2(a.x, a.y), pack2(a.z, a.w), pack2(b.x, b.y), pack2(b.z, b.w));
    ((uint4*)dst)[i] = o;
  }
}
DI void transpose_cvt(const float* __restrict__ src, int R, int C, u16* __restrict__ dst, int Cpad, float* tile, int bid, int nb) {
  const int tid = threadIdx.x;
  const int tr = R / 64, tc = Cpad / 64;
  for (int it = bid; it < tr * tc; it += nb) {
    const int r0 = (it / tc) * 64, c0 = (it % tc) * 64;
#pragma unroll
    for (int ps = 0; ps < 4; ++ps) {
      int r = ps * 16 + (tid >> 4), c = (tid & 15) * 4;
      float4 v = make_float4(0.f, 0.f, 0.f, 0.f);
      if (c0 + c < C) v = *(const float4*)(src + (size_t)(r0 + r) * C + c0 + c);
      tile[(c + 0) * 65 + r] = v.x; tile[(c + 1) * 65 + r] = v.y; tile[(c + 2) * 65 + r] = v.z; tile[(c + 3) * 65 + r] = v.w;
    }
    __syncthreads();
    {
      int c = tid >> 2, part = tid & 3;
      const float* tp = tile + c * 65 + part * 16;
      uint4 o0 = make_uint4(pack2(tp[0], tp[1]), pack2(tp[2], tp[3]), pack2(tp[4], tp[5]), pack2(tp[6], tp[7]));
      uint4 o1 = make_uint4(pack2(tp[8], tp[9]), pack2(tp[10], tp[11]), pack2(tp[12], tp[13]), pack2(tp[14], tp[15]));
      uint4* dp = (uint4*)(dst + (size_t)(c0 + c) * R + r0 + part * 16);
      dp[0] = o0; dp[1] = o1;
    }
    __syncthreads();
  }
}

typedef float v32f __attribute__((ext_vector_type(32)));
typedef _Float16 v32h __attribute__((ext_vector_type(32)));
typedef unsigned v6u __attribute__((ext_vector_type(6)));
constexpr int ROWB = 1536;
DI void quant_rows_fp6(const float* __restrict__ src, unsigned char* __restrict__ dst, float* __restrict__ sc, int row0, int nrows) {
  const int lane = threadIdx.x & 63;
  for (int row = row0 + (threadIdx.x >> 6); row < row0 + nrows; row += 4) {
    const float* sp = src + (size_t)row * 2048 + lane * 4;
    float4 v[8];
    float am = 0.f;
#pragma unroll
    for (int j = 0; j < 8; ++j) {
      float4 t = *(const float4*)(sp + j * 256);
      v[j] = t;
      am = fmaxf(am, fmaxf(fmaxf(fabsf(t.x), fabsf(t.y)), fmaxf(fabsf(t.z), fabsf(t.w))));
    }
    am = wave_max(am);
    const float scale = am > 0.f ? 7.0f / am : 1.0f;
    if (lane == 0) sc[row] = am > 0.f ? am * (1.0f / 7.0f) : 1.0f;
    v32h h;
#pragma unroll
    for (int j = 0; j < 8; ++j) {
      h[j * 4 + 0] = (_Float16)(v[j].x * scale); h[j * 4 + 1] = (_Float16)(v[j].y * scale);
      h[j * 4 + 2] = (_Float16)(v[j].z * scale); h[j * 4 + 3] = (_Float16)(v[j].w * scale);
    }
    const v6u q = __builtin_amdgcn_cvt_scalef32_pk32_fp6_f16(h, 1.0f);
    unsigned char* dp = dst + (size_t)row * ROWB;
    *(uint4*)(dp + lane * 16) = make_uint4(q[0], q[1], q[2], q[3]);
    *(uint2*)(dp + 1024 + lane * 8) = make_uint2(q[4], q[5]);
  }
}

DI void phase_prep(const Params& p, float* lds) {
  cvt_f32_bf16(p.x, p.XB, (size_t)NTOK * D_MODEL / 8);
  for (int o = blockIdx.x * 256 + threadIdx.x; o < 16 * 8 * 4 * 64; o += gridDim.x * 256) {
    const int ln = o & 63, ks = (o >> 6) & 3, kt = (o >> 8) & 7, hc = o >> 11;
    const float* ksrc = p.pkeys + ((size_t)(hc * 128 + kt * 16 + (ln & 15))) * 128 + ks * 32 + (ln >> 4) * 8;
    const float4 a = *(const float4*)ksrc, b = *(const float4*)(ksrc + 4);
    *(uint4*)(p.PKEYS + (size_t)o * 8) = make_uint4(pack2(a.x, a.y), pack2(a.z, a.w), pack2(b.x, b.y), pack2(b.z, b.w));
  }
  transpose_cvt(p.w_in, 2048, D_IN, p.WINT, HS, lds, blockIdx.x, gridDim.x);
  for (int o = blockIdx.x * 256 + threadIdx.x; o < 2 * 65536; o += gridDim.x * 256) {
    const int kind = o >> 16, r = o & 65535;
    const int ln = r & 63, t = (r >> 6) & 15, ks = r >> 10;
    const float* wsrc = (kind ? p.w1_v : p.w1_k) + (size_t)(ks * 32 + (ln >> 4) * 8) * 256 + t * 16 + (ln & 15);
    uint4 v = make_uint4(pack2(wsrc[0], wsrc[256]), pack2(wsrc[512], wsrc[768]), pack2(wsrc[1024], wsrc[1280]), pack2(wsrc[1536], wsrc[1792]));
    *(uint4*)((kind ? p.W1VT : p.W1KT) + (size_t)r * 8) = v;
  }
  transpose_cvt(p.w2_k, 256, 64, p.W2KT, 64, lds, blockIdx.x, gridDim.x);
  transpose_cvt(p.w2_v, 256, 64, p.W2VT, 64, lds, blockIdx.x, gridDim.x);
}

constexpr int LDS_ROW = 72;
template <class Epi>
DI void gemm_tile(const u16* __restrict__ P, int ldp, const u16* __restrict__ Q, int ldq, int K,
                          int p0, int q0, u16* lds, Epi epi) {
  const int tid = threadIdx.x, lane = tid & 63, w = tid >> 6;
  const int wp = w & 1, wq = w >> 1;
  const int l15 = lane & 15, quad = lane >> 4;
  u16* sP = lds;
  u16* sQ = lds + 128 * LDS_ROW;
  f32x4 acc[4][4];
#pragma unroll
  for (int i = 0; i < 4; ++i)
#pragma unroll
    for (int j = 0; j < 4; ++j) acc[i][j] = f32x4{0.f, 0.f, 0.f, 0.f};
  const int srow = tid >> 3, scc = tid & 7;
  const u16* gp = P + (size_t)(p0 + srow) * ldp + scc * 8;
  const u16* gq = Q + (size_t)(q0 + srow) * ldq + scc * 8;
  const u16* gp1 = gp + (size_t)32 * ldp; const u16* gp2 = gp + (size_t)64 * ldp; const u16* gp3 = gp + (size_t)96 * ldp;
  const u16* gq1 = gq + (size_t)32 * ldq; const u16* gq2 = gq + (size_t)64 * ldq; const u16* gq3 = gq + (size_t)96 * ldq;
  uint4 rp0 = *(const uint4*)gp, rp1 = *(const uint4*)gp1, rp2 = *(const uint4*)gp2, rp3 = *(const uint4*)gp3;
  uint4 rq0 = *(const uint4*)gq, rq1 = *(const uint4*)gq1, rq2 = *(const uint4*)gq2, rq3 = *(const uint4*)gq3;
  uint4 sp0 = *(const uint4*)(gp + 64), sp1 = *(const uint4*)(gp1 + 64), sp2 = *(const uint4*)(gp2 + 64), sp3 = *(const uint4*)(gp3 + 64);
  uint4 sq0 = *(const uint4*)(gq + 64), sq1 = *(const uint4*)(gq1 + 64), sq2 = *(const uint4*)(gq2 + 64), sq3 = *(const uint4*)(gq3 + 64);
  u16* wP = sP + srow * LDS_ROW + scc * 8;
  u16* wQ = sQ + srow * LDS_ROW + scc * 8;
  const int nkt = K / 64;
#define GEMM_COMPUTE() \
  _Pragma("unroll") for (int ks = 0; ks < 2; ++ks) { \
    bf16x8 a[4], b[4]; \
    _Pragma("unroll") for (int i = 0; i < 4; ++i) { \
      a[i] = *(const bf16x8*)(sP + (wp * 64 + i * 16 + l15) * LDS_ROW + ks * 32 + quad * 8); \
      b[i] = *(const bf16x8*)(sQ + (wq * 64 + i * 16 + l15) * LDS_ROW + ks * 32 + quad * 8); } \
    _Pragma("unroll") for (int i = 0; i < 4; ++i) \
      _Pragma("unroll") for (int j = 0; j < 4; ++j) acc[i][j] = MFMA16(a[i], b[j], acc[i][j]); }
  for (int kt = 0; kt < nkt; kt += 2) {
    *(uint4*)(wP) = rp0; *(uint4*)(wP + 32 * LDS_ROW) = rp1; *(uint4*)(wP + 64 * LDS_ROW) = rp2; *(uint4*)(wP + 96 * LDS_ROW) = rp3;
    *(uint4*)(wQ) = rq0; *(uint4*)(wQ + 32 * LDS_ROW) = rq1; *(uint4*)(wQ + 64 * LDS_ROW) = rq2; *(uint4*)(wQ + 96 * LDS_ROW) = rq3;
    __syncthreads();
    if (kt + 2 < nkt) {
      const int ko = (kt + 2) * 64;
      rp0 = *(const uint4*)(gp + ko); rp1 = *(const uint4*)(gp1 + ko); rp2 = *(const uint4*)(gp2 + ko); rp3 = *(const uint4*)(gp3 + ko);
      rq0 = *(const uint4*)(gq + ko); rq1 = *(const uint4*)(gq1 + ko); rq2 = *(const uint4*)(gq2 + ko); rq3 = *(const uint4*)(gq3 + ko);
    }
    GEMM_COMPUTE()
    __syncthreads();
    *(uint4*)(wP) = sp0; *(uint4*)(wP + 32 * LDS_ROW) = sp1; *(uint4*)(wP + 64 * LDS_ROW) = sp2; *(uint4*)(wP + 96 * LDS_ROW) = sp3;
    *(uint4*)(wQ) = sq0; *(uint4*)(wQ + 32 * LDS_ROW) = sq1; *(uint4*)(wQ + 64 * LDS_ROW) = sq2; *(uint4*)(wQ + 96 * LDS_ROW) = sq3;
    __syncthreads();
    if (kt + 3 < nkt) {
      const int ko = (kt + 3) * 64;
      sp0 = *(const uint4*)(gp + ko); sp1 = *(const uint4*)(gp1 + ko); sp2 = *(const uint4*)(gp2 + ko); sp3 = *(const uint4*)(gp3 + ko);
      sq0 = *(const uint4*)(gq + ko); sq1 = *(const uint4*)(gq1 + ko); sq2 = *(const uint4*)(gq2 + ko); sq3 = *(const uint4*)(gq3 + ko);
    }
    GEMM_COMPUTE()
    __syncthreads();
  }
#undef GEMM_COMPUTE
#pragma unroll
  for (int i = 0; i < 4; ++i)
#pragma unroll
    for (int j = 0; j < 4; ++j)
      epi(p0 + wp * 64 + i * 16 + quad * 4, q0 + wq * 64 + j * 16 + l15, acc[i][j]);
}

template <class Epi>
DI void gemm_tile_big(const u16* __restrict__ P, int ldp, const u16* __restrict__ Q, int ldq, int K,
                      int p0, int q0, u16* lds, Epi epi) {
  const int tid = threadIdx.x, lane = tid & 63, w = tid >> 6;
  const int wp = w & 1, wq = w >> 1;
  const int l15 = lane & 15, quad = lane >> 4;
  u16* sP = lds;
  u16* sQ = lds + 128 * LDS_ROW;
  f32x4 acc[4][8];
#pragma unroll
  for (int i = 0; i < 4; ++i)
#pragma unroll
    for (int j = 0; j < 8; ++j) acc[i][j] = f32x4{0.f, 0.f, 0.f, 0.f};
  const int srow = tid >> 3, scc = tid & 7;
  const u16* gp = P + (size_t)(p0 + srow) * ldp + scc * 8;
  const u16* gq = Q + (size_t)(q0 + srow) * ldq + scc * 8;
  const size_t sp32 = (size_t)32 * ldp, sq32 = (size_t)32 * ldq;
  uint4 rp0 = *(const uint4*)gp, rp1 = *(const uint4*)(gp + sp32), rp2 = *(const uint4*)(gp + 2 * sp32), rp3 = *(const uint4*)(gp + 3 * sp32);
  uint4 rq0 = *(const uint4*)gq, rq1 = *(const uint4*)(gq + sq32), rq2 = *(const uint4*)(gq + 2 * sq32), rq3 = *(const uint4*)(gq + 3 * sq32);
  uint4 rq4 = *(const uint4*)(gq + 4 * sq32), rq5 = *(const uint4*)(gq + 5 * sq32), rq6 = *(const uint4*)(gq + 6 * sq32), rq7 = *(const uint4*)(gq + 7 * sq32);
  u16* wP = sP + srow * LDS_ROW + scc * 8;
  u16* wQ = sQ + srow * LDS_ROW + scc * 8;
  const int nkt = K / 64;
  for (int kt = 0; kt < nkt; ++kt) {
    *(uint4*)(wP) = rp0; *(uint4*)(wP + 32 * LDS_ROW) = rp1; *(uint4*)(wP + 64 * LDS_ROW) = rp2; *(uint4*)(wP + 96 * LDS_ROW) = rp3;
    *(uint4*)(wQ) = rq0; *(uint4*)(wQ + 32 * LDS_ROW) = rq1; *(uint4*)(wQ + 64 * LDS_ROW) = rq2; *(uint4*)(wQ + 96 * LDS_ROW) = rq3;
    *(uint4*)(wQ + 128 * LDS_ROW) = rq4; *(uint4*)(wQ + 160 * LDS_ROW) = rq5; *(uint4*)(wQ + 192 * LDS_ROW) = rq6; *(uint4*)(wQ + 224 * LDS_ROW) = rq7;
    __syncthreads();
    if (kt + 1 < nkt) {
      const int ko = (kt + 1) * 64;
      rp0 = *(const uint4*)(gp + ko); rp1 = *(const uint4*)(gp + sp32 + ko); rp2 = *(const uint4*)(gp + 2 * sp32 + ko); rp3 = *(const uint4*)(gp + 3 * sp32 + ko);
      rq0 = *(const uint4*)(gq + ko); rq1 = *(const uint4*)(gq + sq32 + ko); rq2 = *(const uint4*)(gq + 2 * sq32 + ko); rq3 = *(const uint4*)(gq + 3 * sq32 + ko);
      rq4 = *(const uint4*)(gq + 4 * sq32 + ko); rq5 = *(const uint4*)(gq + 5 * sq32 + ko); rq6 = *(const uint4*)(gq + 6 * sq32 + ko); rq7 = *(const uint4*)(gq + 7 * sq32 + ko);
    }
    {
#define LDA_(dst, ks) _Pragma("unroll") for (int i = 0; i < 4; ++i) dst[i] = *(const bf16x8*)(sP + (wp * 64 + i * 16 + l15) * LDS_ROW + (ks) * 32 + quad * 8)
#define LDB_(dst, ks, jh) _Pragma("unroll") for (int j = 0; j < 4; ++j) dst[j] = *(const bf16x8*)(sQ + (wq * 128 + ((jh) * 4 + j) * 16 + l15) * LDS_ROW + (ks) * 32 + quad * 8)
#define MM_(a, b, jh) do { __builtin_amdgcn_s_setprio(1); _Pragma("unroll") for (int i = 0; i < 4; ++i) _Pragma("unroll") for (int j = 0; j < 4; ++j) acc[i][(jh) * 4 + j] = MFMA16(a[i], b[j], acc[i][(jh) * 4 + j]); __builtin_amdgcn_s_setprio(0); } while (0)
#define SCHED_ __builtin_amdgcn_sched_barrier(0)
      bf16x8 a[4], b0[4], b1[4];
      LDA_(a, 0); LDB_(b0, 0, 0); LDB_(b1, 0, 1);
      SCHED_;
      MM_(a, b0, 0);
      SCHED_;
      LDB_(b0, 1, 0);
      SCHED_;
      MM_(a, b1, 1);
      SCHED_;
      LDA_(a, 1); LDB_(b1, 1, 1);
      SCHED_;
      MM_(a, b0, 0);
      SCHED_;
      MM_(a, b1, 1);
#undef LDA_
#undef LDB_
#undef MM_
#undef SCHED_
    }
    __syncthreads();
  }
#pragma unroll
  for (int i = 0; i < 4; ++i)
#pragma unroll
    for (int j = 0; j < 8; ++j)
      epi(p0 + wp * 64 + i * 16 + quad * 4, q0 + wq * 128 + j * 16 + l15, acc[i][j]);
}

template <class Epi>
DI void gemm_tile_glds(const u16* __restrict__ P, int ldp, const u16* __restrict__ Q, int ldq, int K,
                       int p0, int q0, unsigned char* lds, Epi epi) {
  const int tid = threadIdx.x, lane = tid & 63, w = tid >> 6;
  const int wp = w & 1, wq = w >> 1;
  const int l15 = lane & 15, quad = lane >> 4;
  f32x4 acc[4][4];
#pragma unroll
  for (int i = 0; i < 4; ++i)
#pragma unroll
    for (int j = 0; j < 4; ++j) acc[i][j] = f32x4{0.f, 0.f, 0.f, 0.f};
  const int srow = w * 8 + (lane >> 3);
  const int csrc = (lane & 7) ^ ((srow >> 1) & 7);
  const u16* gp = P + (size_t)(p0 + srow) * ldp + csrc * 8;
  const u16* gq = Q + (size_t)(q0 + srow) * ldq + csrc * 8;
  const unsigned dP = (unsigned)__builtin_amdgcn_readfirstlane((int)(unsigned)(size_t)(lds + (w * 8) * 128));
  const unsigned dQ = dP + 16384u;
#define GLDS16(gsrc_, ldsb_) do { unsigned keep_; \
    asm volatile("s_mov_b32 %0, m0\n\ts_mov_b32 m0, %2\n\ts_nop 0\n\tglobal_load_lds_dwordx4 %1, off\n\ts_mov_b32 m0, %0" \
                 : "=&s"(keep_) : "v"(gsrc_), "s"(ldsb_) : "memory"); } while (0)
#define GLDS_ISSUE(kt_, buf_) do { \
    _Pragma("unroll") for (int j = 0; j < 4; ++j) { \
      GLDS16(gp + (size_t)(32 * j) * ldp + (kt_) * 64, dP + (unsigned)(j * 4096 + (buf_) * 32768)); \
      GLDS16(gq + (size_t)(32 * j) * ldq + (kt_) * 64, dQ + (unsigned)(j * 4096 + (buf_) * 32768)); } } while (0)
  GLDS_ISSUE(0, 0);
  const int nkt = K / 64;
  const int sw = l15 >> 1;
  const unsigned char* rP = lds + (wp * 64 + l15) * 128;
  const unsigned char* rQ = lds + 16384 + (wq * 64 + l15) * 128;
  for (int kt = 0; kt < nkt; ++kt) {
    asm volatile("s_waitcnt vmcnt(0)" ::: "memory");
    __builtin_amdgcn_s_barrier();
    if (kt + 1 < nkt) GLDS_ISSUE(kt + 1, (kt + 1) & 1);
    const int bo = (kt & 1) * 32768;
#pragma unroll
    for (int ks = 0; ks < 2; ++ks) {
      const int co = ((ks * 4 + quad) ^ sw) * 16;
      bf16x8 a[4], b[4];
#pragma unroll
      for (int i = 0; i < 4; ++i) {
        a[i] = *(const bf16x8*)(rP + bo + i * 2048 + co);
        b[i] = *(const bf16x8*)(rQ + bo + i * 2048 + co);
      }
#pragma unroll
      for (int i = 0; i < 4; ++i)
#pragma unroll
        for (int j = 0; j < 4; ++j) acc[i][j] = MFMA16(a[i], b[j], acc[i][j]);
    }
  }
#undef GLDS_ISSUE
#undef GLDS16
  __syncthreads();
  if constexpr (Epi::kPairRows) {
#pragma unroll
    for (int j = 0; j < 4; ++j)
#pragma unroll
      for (int i = 0; i < 4; i += 2) {
        const unsigned alo = pack2(acc[i][j][0], acc[i][j][1]), ahi = pack2(acc[i][j][2], acc[i][j][3]);
        const unsigned blo = pack2(acc[i + 1][j][0], acc[i + 1][j][1]), bhi = pack2(acc[i + 1][j][2], acc[i + 1][j][3]);
        auto rl = __builtin_amdgcn_permlane16_swap(alo, blo, false, false);
        auto rh = __builtin_amdgcn_permlane16_swap(ahi, bhi, false, false);
        epi.store8(p0 + wp * 64 + (i + (quad & 1)) * 16 + (quad >> 1) * 8, q0 + wq * 64 + j * 16 + l15, make_uint4(rl[0], rh[0], rl[1], rh[1]));
      }
  } else {
#pragma unroll
    for (int i = 0; i < 4; ++i)
#pragma unroll
      for (int j = 0; j < 4; ++j)
        epi(p0 + wp * 64 + i * 16 + quad * 4, q0 + wq * 64 + j * 16 + l15, acc[i][j]);
  }
}

struct EpiH {
  static constexpr bool kPairRows = true;
  u16* H;
  DI void store8(int pch, int tok, uint4 v) const { *(uint4*)(H + (size_t)tok * HS + pch) = v; }
  DI void operator()(int pch, int tok, f32x4 v) const {
    *(uint2*)(H + (size_t)tok * HS + pch) = make_uint2(pack2(v[0], v[1]), pack2(v[2], v[3]));
  }
};
struct EpiVT {
  static constexpr bool kPairRows = false;
  u16* VT;
  DI void operator()(int tok, int ch, f32x4 v) const {
    int which = (ch >= 2304) ? 1 : 0;
    int cc = ch & 255;
    int g = cc >> 6, d = cc & 63;
    int b = tok >> 12, t = tok & 4095;
    *(uint2*)(VT + ((size_t)((which * 2 + b) * 4 + g) * 64 + d) * 4096 + t) = make_uint2(pack2(v[0], v[1]), pack2(v[2], v[3]));
  }
};
struct EpiMix {
  static constexpr bool kPairRows = false;
  float* Y; const float* x;
  DI void operator()(int c, int tok, f32x4 v) const {
    float4 xv = *(const float4*)(x + (size_t)tok * 2048 + c);
    *(float4*)(Y + (size_t)tok * 2048 + c) = make_float4(DN_ALPHA * xv.x + v[0], DN_ALPHA * xv.y + v[1], DN_ALPHA * xv.z + v[2], DN_ALPHA * xv.w + v[3]);
  }
};
struct EpiPQ {
  static constexpr bool kPairRows = false;
  u16* PQ;
  DI void operator()(int c, int tok, f32x4 v) const {
    const size_t off = ((((size_t)(tok >> 4) * 16 + (c >> 7)) * 4 + ((c >> 5) & 3)) * 64 + ((c >> 3) & 3) * 16 + (tok & 15)) * 8 + (c & 7);
    *(uint2*)(PQ + off) = make_uint2(pack2(v[0], v[1]), pack2(v[2], v[3]));
  }
};

DI void phase_gemm1(const Params& p, u16* lds, volatile LAS unsigned* bcast) {
  for (;;) {
    if (threadIdx.x == 0) bcast[2] = xb_add(&p.BAR[0], 1u);
    __syncthreads();
    const int it = (int)bcast[2];
    __syncthreads();
    if (it >= 37 * 64) break;
    const int ct = it % 37, tt = it / 37;
    const bool isv = (ct == 14 || ct == 15 || ct == 18 || ct == 19);
    if (isv) gemm_tile_glds(p.XB, 2048, p.WINT, 2048, 2048, tt * 128, ct * 128, (unsigned char*)lds, EpiVT{p.VT});
    else     gemm_tile_glds(p.WINT, 2048, p.XB, 2048, 2048, ct * 128, tt * 128, (unsigned char*)lds, EpiH{p.H});
  }
}
DI void phase_gemm_mix(const Params& p, u16* lds) {
  for (int it = blockIdx.x; it < 16 * 64; it += gridDim.x) {
    int ct = it % 16, tt = it / 16;
    gemm_tile_glds(p.WOUTT, 2048, p.MIXB, 2048, 2048, ct * 128, tt * 128, (unsigned char*)lds, EpiMix{p.Y, p.x});
  }
}
DI void phase_gemm_pq(const Params& p, u16* lds) {
  for (int it = blockIdx.x; it < 16 * 64; it += gridDim.x) {
    int ct = it % 16, tt = it / 16;
    gemm_tile_glds(p.WQT, 2048, p.YB, 2048, 2048, ct * 128, tt * 128, (unsigned char*)lds, EpiPQ{p.PQ});
  }
}

DI bf16x8 add_pos(bf16x8 v, float4 a, float4 b) {
  uint4 u = __builtin_bit_cast(uint4, v);
  uint4 r = make_uint4(pack2(bflo(u.x) + a.x, bfhi(u.x) + a.y), pack2(bflo(u.y) + a.z, bfhi(u.y) + a.w),
                       pack2(bflo(u.z) + b.x, bfhi(u.z) + b.y), pack2(bflo(u.w) + b.z, bfhi(u.w) + b.w));
  return __builtin_bit_cast(bf16x8, r);
}
DI void compress_item(const Params& p, int item, u16* hid  ) {
  const int tid = threadIdx.x, lane = tid & 63, w = tid >> 6;
  const int l15 = lane & 15, quad = lane >> 4;
  const int kind = item >> 6;
  const int r0 = (item & 63) * 32;
  const u16* W1T = kind ? p.W1VT : p.W1KT;
  const u16* W2T = kind ? p.W2VT : p.W2KT;
  const float* posp = (kind ? p.pos_v : p.pos_k) + quad * 8;
  const u16* brow[2];
#pragma unroll
  for (int qi = 0; qi < 2; ++qi) {
    int r = r0 + qi * 16 + l15;
    if (r > 2039) r = 2039;
    int g = r & 3, bn = r >> 2;
    int b = bn / 255, n = bn % 255;
    brow[qi] = p.H + (size_t)(b * 4096 + 16 * n) * HS + COL_KV + kind * 256 + g * 64 + quad * 8;
  }
  const u16* arow = W1T + ((size_t)(w * 4) * 64 + lane) * 8;
  f32x4 acc[4][2];
#pragma unroll
  for (int i = 0; i < 4; ++i) { acc[i][0] = f32x4{0.f, 0.f, 0.f, 0.f}; acc[i][1] = f32x4{0.f, 0.f, 0.f, 0.f}; }
#pragma unroll 4
  for (int ks = 0; ks < 64; ++ks) {
    const int l = ks >> 1, d0 = (ks & 1) * 32;
    const float4 pa = *(const float4*)(posp + l * 64 + d0), pb4 = *(const float4*)(posp + l * 64 + d0 + 4);
    bf16x8 b0 = add_pos(ld8(brow[0] + (size_t)l * HS + d0), pa, pb4);
    bf16x8 b1 = add_pos(ld8(brow[1] + (size_t)l * HS + d0), pa, pb4);
#pragma unroll
    for (int i = 0; i < 4; ++i) {
      bf16x8 a = ld8(arow + (size_t)(ks * 16 + i) * 512);
      acc[i][0] = MFMA16(a, b0, acc[i][0]);
      acc[i][1] = MFMA16(a, b1, acc[i][1]);
    }
  }
#pragma unroll
  for (int i = 0; i < 4; ++i)
#pragma unroll
    for (int qi = 0; qi < 2; ++qi) {
      int j = w * 64 + i * 16 + quad * 4;
      float h0 = gelu_tanh(acc[i][qi][0]), h1 = gelu_tanh(acc[i][qi][1]);
      float h2 = gelu_tanh(acc[i][qi][2]), h3 = gelu_tanh(acc[i][qi][3]);
      *(uint2*)(hid + (qi * 16 + l15) * 264 + j) = make_uint2(pack2(h0, h1), pack2(h2, h3));
    }
  __syncthreads();
  f32x4 o2[2] = {f32x4{0.f, 0.f, 0.f, 0.f}, f32x4{0.f, 0.f, 0.f, 0.f}};
#pragma unroll
  for (int ks = 0; ks < 8; ++ks) {
    bf16x8 a = ld8(W2T + (size_t)(w * 16 + l15) * 256 + ks * 32 + quad * 8);
#pragma unroll
    for (int qi = 0; qi < 2; ++qi) {
      bf16x8 b = *(const bf16x8*)(hid + (qi * 16 + l15) * 264 + ks * 32 + quad * 8);
      o2[qi] = MFMA16(a, b, o2[qi]);
    }
  }
#pragma unroll
  for (int qi = 0; qi < 2; ++qi) {
    int r = r0 + qi * 16 + l15;
    if (r < 2040) {
      int g = r & 3, bn = r >> 2;
      int b = bn / 255, n = bn % 255;
      int d = w * 16 + quad * 4;
      if (kind == 0) {
        *(uint2*)(p.KC + ((((size_t)(b * 4 + g) * 16 + (n >> 4)) * 2 + (d >> 5)) * 64 + ((d >> 3) & 3) * 16 + (n & 15)) * 8 + (d & 7)) = make_uint2(pack2(o2[qi][0], o2[qi][1]), pack2(o2[qi][2], o2[qi][3]));
      } else {
        const int m = n & 31;
        u16* vp = p.VCT + (((((size_t)(b * 4 + g) * 4 + (n >> 6)) * 2 + ((n >> 5) & 1)) * 4 + (d >> 4)) * 64 + ((m & 15) >> 2) * 16 + (d & 15)) * 8 + (m & 3) + ((m >> 4) << 2);
        vp[0] = f2bf(o2[qi][0]); vp[8] = f2bf(o2[qi][1]); vp[16] = f2bf(o2[qi][2]); vp[24] = f2bf(o2[qi][3]);
      }
    }
  }
  if ((item & 63) == 0) {
    if (kind == 0) {
      if (tid < 8 * 64) { int bg = tid >> 5;   (void)bg; }
      for (int e = tid; e < 8 * 64; e += 256) { const int bg = e >> 6, dd = e & 63; p.KC[((((size_t)bg * 16 + 15) * 2 + (dd >> 5)) * 64 + ((dd >> 3) & 3) * 16 + 15) * 8 + (dd & 7)] = 0; }
    } else {
      for (int e = tid; e < 8 * 64; e += 256) { const int bg = e >> 6, dd = e & 63; p.VCT[(((((size_t)bg * 4 + 3) * 2 + 1) * 4 + (dd >> 4)) * 64 + 3 * 16 + (dd & 15)) * 8 + 7] = 0; }
    }
  }
  __syncthreads();
}

constexpr int CT = 16;
DI void conv_item(const Params& p, int item, float* red) {
  const int tid = threadIdx.x;
  const int tok0 = item * CT;
  const int t0 = tok0 & 4095;
  const int c = tid * 4;
  float res[CT][4];
  {
    float4 bv = *(const float4*)(p.dw_b + c);
#pragma unroll
    for (int o = 0; o < CT; ++o) { res[o][0] = bv.x; res[o][1] = bv.y; res[o][2] = bv.z; res[o][3] = bv.w; }
  }
  {
    const int tt0 = (t0 >= 30) ? 0 : (30 - t0);
    const u16* hp = p.H + (size_t)(tok0 - 30 + tt0) * HS + COL_CONV + c;
    const float* wp = p.dw_w + c;
    float4 wr[CT];
#pragma unroll
    for (int o = 0; o < CT; ++o) {
      const int tap = tt0 - o;
      wr[o] = (tap >= 0 && tap <= 30) ? *(const float4*)(wp + tap * 1024) : make_float4(0.f, 0.f, 0.f, 0.f);
    }
#pragma unroll 8
    for (int tt = tt0; tt < 30 + CT; ++tt, hp += HS) {
      const uint2 av = *(const uint2*)hp;
      const uint2 gv = *(const uint2*)(hp + 1024);
      const float4 wnext = (tt + 1 <= 30) ? *(const float4*)(wp + (tt + 1) * 1024) : make_float4(0.f, 0.f, 0.f, 0.f);
      const float u0 = bflo(av.x) * sigmoidf_(bflo(gv.x));
      const float u1 = bfhi(av.x) * sigmoidf_(bfhi(gv.x));
      const float u2 = bflo(av.y) * sigmoidf_(bflo(gv.y));
      const float u3 = bfhi(av.y) * sigmoidf_(bfhi(gv.y));
#pragma unroll
      for (int o = 0; o < CT; ++o) {
        res[o][0] += wr[o].x * u0;
        res[o][1] += wr[o].y * u1;
        res[o][2] += wr[o].z * u2;
        res[o][3] += wr[o].w * u3;
      }
#pragma unroll
      for (int o = CT - 1; o > 0; --o) wr[o] = wr[o - 1];
      wr[0] = wnext;
    }
  }
  float mu[CT], rs[CT];
  {
    const int lane = tid & 63, w = tid >> 6;
#pragma unroll
    for (int o = 0; o < CT; ++o) {
      const float s = wave_sum(res[o][0] + res[o][1] + res[o][2] + res[o][3]);
      if (lane == 0) red[w * CT + o] = s;
    }
    __syncthreads();
#pragma unroll
    for (int o = 0; o < CT; ++o) mu[o] = (red[o] + red[CT + o] + red[2 * CT + o] + red[3 * CT + o]) * (1.0f / 1024.0f);
    __syncthreads();
#pragma unroll
    for (int o = 0; o < CT; ++o) {
      const float a = res[o][0] - mu[o], b = res[o][1] - mu[o], c2 = res[o][2] - mu[o], d = res[o][3] - mu[o];
      const float s = wave_sum(a * a + b * b + c2 * c2 + d * d);
      if (lane == 0) red[w * CT + o] = s;
    }
    __syncthreads();
#pragma unroll
    for (int o = 0; o < CT; ++o) rs[o] = rsqrtf((red[o] + red[CT + o] + red[2 * CT + o] + red[3 * CT + o]) * (1.0f / 1024.0f) + LN_EPS);
    __syncthreads();
  }
  {
    const float4 gv = *(const float4*)(p.cln_g + c), bv = *(const float4*)(p.cln_b + c);
#pragma unroll
    for (int o = 0; o < CT; ++o) {
      float y0 = (res[o][0] - mu[o]) * rs[o] * gv.x + bv.x;
      float y1 = (res[o][1] - mu[o]) * rs[o] * gv.y + bv.y;
      float y2 = (res[o][2] - mu[o]) * rs[o] * gv.z + bv.z;
      float y3 = (res[o][3] - mu[o]) * rs[o] * gv.w + bv.w;
      y0 = y0 * sigmoidf_(y0); y1 = y1 * sigmoidf_(y1); y2 = y2 * sigmoidf_(y2); y3 = y3 * sigmoidf_(y3);
      *(uint2*)(p.MIXB + (size_t)(tok0 + o) * 2048 + 1024 + c) = make_uint2(pack2(y0, y1), pack2(y2, y3));
    }
  }
}

DI void qk4(const u16* __restrict__ Kb, int kstride, int key0, bf16x8 qf0, bf16x8 qf1, f32x4 (&s)[4], int l15, int quad) {
#pragma unroll
  for (int kt = 0; kt < 4; ++kt) {
    const u16* kr = Kb + (size_t)(key0 + kt * 16 + l15) * kstride + quad * 8;
    bf16x8 a0 = ld8(kr), a1 = ld8(kr + 32);
    f32x4 z = f32x4{0.f, 0.f, 0.f, 0.f};
    z = MFMA16(a0, qf0, z);
    z = MFMA16(a1, qf1, z);
    s[kt] = z;
  }
}
DI void qk4f(const u16* __restrict__ KCF, int c, bf16x8 qf0, bf16x8 qf1, f32x4 (&s)[4], int lane) {
#pragma unroll
  for (int kt = 0; kt < 4; ++kt) {
    const u16* kr = KCF + ((size_t)((c * 4 + kt) * 2) * 64 + lane) * 8;
    bf16x8 a0 = ld8(kr), a1 = ld8(kr + 512);
    f32x4 z = f32x4{0.f, 0.f, 0.f, 0.f};
    z = MFMA16(a0, qf0, z);
    z = MFMA16(a1, qf1, z);
    s[kt] = z;
  }
}
DI void pv4(const u16* __restrict__ Vt, int vstride, int key0, const f32x4 (&s)[4], f32x4 (&o)[4], int l15, int quad) {
#pragma unroll
  for (int ks2 = 0; ks2 < 2; ++ks2) {
    bf16x8 pb = packp(s[2 * ks2], s[2 * ks2 + 1]);
#pragma unroll
    for (int dt = 0; dt < 4; ++dt) {
      const u16* vr = Vt + (size_t)(dt * 16 + l15) * vstride + key0 + ks2 * 32 + quad * 4;
      uint2 lo = *(const uint2*)vr, hi = *(const uint2*)(vr + 16);
      o[dt] = MFMA16(comb(lo, hi), pb, o[dt]);
    }
  }
}
DI void pv4f(const u16* __restrict__ VCF, int c, const f32x4 (&s)[4], f32x4 (&o)[4], int lane) {
#pragma unroll
  for (int ks2 = 0; ks2 < 2; ++ks2) {
    bf16x8 pb = packp(s[2 * ks2], s[2 * ks2 + 1]);
#pragma unroll
    for (int dt = 0; dt < 4; ++dt)
      o[dt] = MFMA16(ld8(VCF + ((size_t)(((c * 2 + ks2) * 4 + dt) * 64) + lane) * 8), pb, o[dt]);
  }
}
DI void flash_block(const u16* __restrict__ Kb, const u16* __restrict__ Vt, int key0, int tq, float slope, bool rowok, int win,
                    bf16x8 qf0, bf16x8 qf1, float& m, float& l, f32x4 (&o)[4], int l15, int quad) {
  f32x4 s[4];
  qk4(Kb, HS, key0, qf0, qf1, s, l15, quad);
  float bm = -1e30f;
#pragma unroll
  for (int kt = 0; kt < 4; ++kt)
#pragma unroll
    for (int i = 0; i < 4; ++i) {
      int dist = tq - (key0 + kt * 16 + quad * 4 + i);
      bool valid = rowok && dist >= 0 && dist < win;
      float sv = valid ? (s[kt][i] * 0.125f - slope * (float)dist) : -1e30f;
      s[kt][i] = sv;
      bm = fmaxf(bm, sv);
    }
  bm = quad_maxf(bm);
  const float mn = fmaxf(m, bm);
  const float alpha = __expf(m - mn);
  float ps = 0.f;
#pragma unroll
  for (int kt = 0; kt < 4; ++kt)
#pragma unroll
    for (int i = 0; i < 4; ++i) {
      float sv = s[kt][i];
      float pv = (sv > -1e29f) ? __expf(sv - mn) : 0.f;
      s[kt][i] = pv;
      ps += pv;
    }
  ps = quad_sumf(ps);
  l = l * alpha + ps;
  m = mn;
#pragma unroll
  for (int dt = 0; dt < 4; ++dt) { o[dt][0] *= alpha; o[dt][1] *= alpha; o[dt][2] *= alpha; o[dt][3] *= alpha; }
  pv4(Vt, 4096, key0, s, o, l15, quad);
}

DI void nsa_item(const Params& p, int item, float* implds  , unsigned char* kvlds  ) {
  const int tid = threadIdx.x, lane = tid & 63, w = tid >> 6;
  const int l15 = lane & 15, quad = lane >> 4;
  int qt = item & 255; const int g = (item >> 8) & 3, b = item >> 10;
  const int t0 = qt * 16, tq = t0 + w * 4 + (l15 >> 2);
  const int hh = g * 4 + (l15 & 3);
  const float slope = exp2f(-0.5f * (float)(hh + 1));
  const size_t tokbase = (size_t)b * 4096;
  const u16* Hq = p.H + (tokbase + tq) * HS + hh * 64;
  const bf16x8 qf0 = ld8(Hq + quad * 8), qf1 = ld8(Hq + 32 + quad * 8);
  const u16* gp = p.H + (tokbase + tq) * HS + COL_GATE + hh * 3;
  const float g0 = sigmoidf_(bf2f(gp[0])), g1 = sigmoidf_(bf2f(gp[1])), g2 = sigmoidf_(bf2f(gp[2]));

  const u16* KCb = p.KC + ((size_t)(b * 4 + g) * 256) * 64;
  const u16* VCTb = p.VCT + ((size_t)(b * 4 + g) * 64) * 256;
  const int nmax = (t0 - 16) >> 4;
  const int nch = (nmax < 0) ? 0 : ((nmax >> 6) + 1);
  float mc = -1e30f, lc = 0.f;
#pragma unroll 1
  for (int c = 0; c < nch; ++c) {
    f32x4 s[4];
    qk4f(KCb, c, qf0, qf1, s, lane);
    float bm = -1e30f;
#pragma unroll
    for (int kt = 0; kt < 4; ++kt)
#pragma unroll
      for (int i = 0; i < 4; ++i) {
        int ce = 16 * (c * 64 + kt * 16 + quad * 4 + i) + 31;
        float sv = (ce <= tq) ? (s[kt][i] * 0.125f - slope * (float)(tq - ce)) : -1e30f;
        s[kt][i] = sv;
        bm = fmaxf(bm, sv);
      }
    bm = quad_maxf(bm);
    const float mn = fmaxf(mc, bm);
    float ps = 0.f;
#pragma unroll
    for (int kt = 0; kt < 4; ++kt)
#pragma unroll
      for (int i = 0; i < 4; ++i) ps += (s[kt][i] > -1e29f) ? __expf(s[kt][i] - mn) : 0.f;
    ps = quad_sumf(ps);
    lc = lc * __expf(mc - mn) + ps;
    mc = mn;
  }
  const float inv = lc > 0.f ? 1.0f / lc : 0.f;
  f32x4 oacc[4];
#pragma unroll
  for (int dt = 0; dt < 4; ++dt) oacc[dt] = f32x4{0.f, 0.f, 0.f, 0.f};
  {
    float* lastlds = (float*)kvlds;
#pragma unroll 1
    for (int c = 0; c < 4; ++c) {
      f32x4 s[4];
      if (c < nch) {
        qk4f(KCb, c, qf0, qf1, s, lane);
#pragma unroll
        for (int kt = 0; kt < 4; ++kt)
#pragma unroll
          for (int i = 0; i < 4; ++i) {
            int ce = 16 * (c * 64 + kt * 16 + quad * 4 + i) + 31;
            float sv = s[kt][i] * 0.125f - slope * (float)(tq - ce);
            s[kt][i] = (ce <= tq) ? __expf(sv - mc) * inv : 0.f;
          }
        pv4f(VCTb, c, s, oacc, lane);
      } else {
#pragma unroll
        for (int kt = 0; kt < 4; ++kt) s[kt] = f32x4{0.f, 0.f, 0.f, 0.f};
      }
#pragma unroll
      for (int kt = 0; kt < 4; ++kt) {
        implds[(w * 16 + c * 4 + kt) * 64 + lane] = s[kt][0] + s[kt][1] + s[kt][2] + s[kt][3];
        lastlds[(w * 16 + c * 4 + kt) * 64 + lane] = s[kt][3];
      }
    }
  }
#pragma unroll
  for (int dt = 0; dt < 4; ++dt) { oacc[dt][0] *= g0; oacc[dt][1] *= g0; oacc[dt][2] *= g0; oacc[dt][3] *= g0; }
  const int cur = tq >> 6;
  u64 sel = 0;
  {
    int v[16];
#pragma unroll
    for (int jj = 0; jj < 16; ++jj) {
      const int j = jj * 4 + quad;
      float a = implds[(w * 16 + jj) * 64 + lane];
      {
        const float* lastlds = (const float*)kvlds;
        const int pj = (quad > 0) ? jj : jj - 1;
        const int pl = (quad > 0) ? lane - 16 : lane + 48;
        const float nbv = lastlds[(w * 16 + (pj < 0 ? 0 : pj)) * 64 + pl];
        a += (pj < 0) ? 0.f : nbv;
      }
      a += dppf<0xB1>(a);
      a += dppf<0x4E>(a);
      const bool forced = (j == 0) || (j == cur) || (j == cur - 1);
      if (forced) a += 1.0e4f;
      if (j * 64 > tq) a = -1.0f;
      v[jj] = (__float_as_int(a) & ~63) | (63 - j);
    }
#pragma unroll 1
    for (int r = 0; r < 16; ++r) {
      int bv = v[0];
#pragma unroll
      for (int jj = 1; jj < 16; ++jj) bv = max(bv, v[jj]);
      bv = quad_maxi(bv);
      sel |= 1ull << (63 - (bv & 63));
#pragma unroll
      for (int jj = 0; jj < 16; ++jj) v[jj] = (v[jj] == bv) ? (int)0x80000000 : v[jj];
    }
    if (cur < 63) sel &= ((1ull << (cur + 1)) - 1ull);
  }
  u64 U, Uw;
  {
    unsigned lo = (unsigned)sel, hi = (unsigned)(sel >> 32);
    lo = row_or(lo); hi = row_or(hi);
    lo = __builtin_amdgcn_readfirstlane(lo); hi = __builtin_amdgcn_readfirstlane(hi);
    Uw = ((u64)hi << 32) | lo;
    unsigned* ux = (unsigned*)(kvlds + 2 * 64 * 72 * 2);
    if (lane == 0) { ux[w * 2] = lo; ux[w * 2 + 1] = hi; }
    __syncthreads();
    lo = ux[0] | ux[2] | ux[4] | ux[6]; hi = ux[1] | ux[3] | ux[5] | ux[7];
    lo = __builtin_amdgcn_readfirstlane(lo); hi = __builtin_amdgcn_readfirstlane(hi);
    U = ((u64)hi << 32) | lo;
  }
  {
    float ms = -1e30f, ls = 0.f, mw = -1e30f, lw = 0.f;
    f32x4 os[4], ow[4];
#pragma unroll
    for (int dt = 0; dt < 4; ++dt) { os[dt] = f32x4{0.f, 0.f, 0.f, 0.f}; ow[dt] = f32x4{0.f, 0.f, 0.f, 0.f}; }
    int jw = t0 - 511; if (jw < 0) jw = 0; jw >>= 6;
    const int jhi = (t0 + 15) >> 6;
    const int nsteps = __builtin_popcountll(U) + (jhi - jw + 1);
    const float SL2 = slope * 1.4426950408889634f, QS = 0.125f * 1.4426950408889634f;
    const float aq = -SL2 * (float)tq;
    float cE[4][4];
#pragma unroll
    for (int kt = 0; kt < 4; ++kt)
#pragma unroll
      for (int i = 0; i < 4; ++i) cE[kt][i] = SL2 * (float)(kt * 16 + quad * 4 + i);
    u16* tiles = (u16*)kvlds;
    const int srow = tid >> 3, scc = tid & 7;
    const u16* kbl = p.H + (tokbase + srow) * HS + COL_KV + 2 * 256 + g * 64 + scc * 8;
    const u16* vbl = p.VT + ((size_t)((0 * 2 + b) * 4 + g) * 64 + srow) * 4096 + scc * 8;
    uint4 rk0, rk1, rv0, rv1;
    int nkind, nj;
#define NSA_NEXT() do { if (U) { nkind = 0; nj = __builtin_ctzll(U); U &= U - 1; } else { nkind = 1; nj = jw++; } } while (0)
#define NSA_FETCH() do { const u16* kb_ = kbl + (size_t)(nj * 64) * HS + nkind * 512; \
      const u16* vb_ = vbl + (size_t)nkind * (2 * 4 * 64 * 4096) + nj * 64; \
      rk0 = *(const uint4*)kb_; rk1 = *(const uint4*)(kb_ + (size_t)32 * HS); \
      rv0 = *(const uint4*)vb_; rv1 = *(const uint4*)(vb_ + (size_t)32 * 4096); } while (0)
    NSA_NEXT();
    NSA_FETCH();
#pragma unroll 1
    for (int st = 0; st < nsteps; ++st) {
      u16* sK = tiles + (st & 1) * (2 * 64 * 72);
      u16* sV = sK + 64 * 72;
      *(uint4*)(sK + srow * 72 + scc * 8) = rk0; *(uint4*)(sK + (srow + 32) * 72 + scc * 8) = rk1;
      *(uint4*)(sV + srow * 72 + scc * 8) = rv0; *(uint4*)(sV + (srow + 32) * 72 + scc * 8) = rv1;
      const int ckind = nkind, cj = nj;
      __syncthreads();
      if (st + 1 < nsteps) { NSA_NEXT(); NSA_FETCH(); }
      if (ckind || ((Uw >> cj) & 1ull)) {
      const int key0 = cj * 64;
      f32x4 s[4];
#pragma unroll
      for (int kt = 0; kt < 4; ++kt) {
        const u16* kr = sK + (kt * 16 + l15) * 72 + quad * 8;
        bf16x8 a0 = *(const bf16x8*)kr, a1 = *(const bf16x8*)(kr + 32);
        f32x4 z = f32x4{0.f, 0.f, 0.f, 0.f};
        z = MFMA16(a0, qf0, z);
        z = MFMA16(a1, qf1, z);
        s[kt] = z;
      }
      const float mold = ckind ? mw : ms;
      const float base = aq + SL2 * (float)key0;
      const int thr2 = tq - key0 - quad * 4;
      float bm = -1e30f;
      if (ckind) {
        const int thr3 = thr2 - 512;
#pragma unroll
        for (int kt = 0; kt < 4; ++kt)
#pragma unroll
          for (int i = 0; i < 4; ++i) {
            const float x = fmaf(s[kt][i], QS, base + cE[kt][i]);
            const bool valid = (kt * 16 + i <= thr2) && (kt * 16 + i > thr3);
            const float sv = valid ? x : -1e30f;
            s[kt][i] = sv;
            bm = fmaxf(bm, sv);
          }
      } else {
        const bool rowok = (bool)((sel >> cj) & 1ull);
#pragma unroll
        for (int kt = 0; kt < 4; ++kt)
#pragma unroll
          for (int i = 0; i < 4; ++i) {
            const float x = fmaf(s[kt][i], QS, base + cE[kt][i]);
            const bool valid = rowok && (kt * 16 + i <= thr2);
            const float sv = valid ? x : -1e30f;
            s[kt][i] = sv;
            bm = fmaxf(bm, sv);
          }
      }
      bm = quad_maxf(bm);
      const float mn = fmaxf(mold, bm);
      const float alpha = __builtin_amdgcn_exp2f(mold - mn);
      const float mne = fmaxf(mn, -1e20f);
      float ps = 0.f;
#pragma unroll
      for (int kt = 0; kt < 4; ++kt)
#pragma unroll
        for (int i = 0; i < 4; ++i) {
          const float pv = __builtin_amdgcn_exp2f(s[kt][i] - mne);
          s[kt][i] = pv;
          ps += pv;
        }
      ps = quad_sumf(ps);
      bf16x8 pb0 = packp(s[0], s[1]), pb1 = packp(s[2], s[3]);
      if (ckind) {
        lw = lw * alpha + ps; mw = mn;
#pragma unroll
        for (int dt = 0; dt < 4; ++dt) {
          ow[dt][0] *= alpha; ow[dt][1] *= alpha; ow[dt][2] *= alpha; ow[dt][3] *= alpha;
          const u16* vr = sV + (dt * 16 + l15) * 72 + quad * 4;
          ow[dt] = MFMA16(comb(*(const uint2*)vr, *(const uint2*)(vr + 16)), pb0, ow[dt]);
          ow[dt] = MFMA16(comb(*(const uint2*)(vr + 32), *(const uint2*)(vr + 48)), pb1, ow[dt]);
        }
      } else {
        ls = ls * alpha + ps; ms = mn;
#pragma unroll
        for (int dt = 0; dt < 4; ++dt) {
          os[dt][0] *= alpha; os[dt][1] *= alpha; os[dt][2] *= alpha; os[dt][3] *= alpha;
          const u16* vr = sV + (dt * 16 + l15) * 72 + quad * 4;
          os[dt] = MFMA16(comb(*(const uint2*)vr, *(const uint2*)(vr + 16)), pb0, os[dt]);
          os[dt] = MFMA16(comb(*(const uint2*)(vr + 32), *(const uint2*)(vr + 48)), pb1, os[dt]);
        }
      }
      }
    }
#undef NSA_NEXT
#undef NSA_FETCH
    __syncthreads();
    const float scs = g1 / ls, scw = g2 / lw;
#pragma unroll
    for (int dt = 0; dt < 4; ++dt) {
      oacc[dt][0] += scs * os[dt][0] + scw * ow[dt][0]; oacc[dt][1] += scs * os[dt][1] + scw * ow[dt][1];
      oacc[dt][2] += scs * os[dt][2] + scw * ow[dt][2]; oacc[dt][3] += scs * os[dt][3] + scw * ow[dt][3];
    }
  }
  u16* op = p.MIXB + (tokbase + tq) * 2048 + hh * 64 + quad * 4;
#pragma unroll
  for (int dt = 0; dt < 4; ++dt)
    *(uint2*)(op + dt * 16) = make_uint2(pack2(oacc[dt][0], oacc[dt][1]), pack2(oacc[dt][2], oacc[dt][3]));
}

DI void ln1_item(const Params& p, int item) {
  const int lane = threadIdx.x & 63, w = threadIdx.x >> 6;
  const int row = item * 4 + w;
  float* yr = p.Y + (size_t)row * 2048;
  float4 v[8];
  float s = 0.f;
#pragma unroll
  for (int i = 0; i < 8; ++i) { v[i] = *(const float4*)(yr + (lane + 64 * i) * 4); s += v[i].x + v[i].y + v[i].z + v[i].w; }
  const float mu = wave_sum(s) * (1.0f / 2048.0f);
  float q = 0.f;
#pragma unroll
  for (int i = 0; i < 8; ++i) { float a = v[i].x - mu, b = v[i].y - mu, c = v[i].z - mu, d = v[i].w - mu; q += a * a + b * b + c * c + d * d; }
  const float rs = rsqrtf(wave_sum(q) * (1.0f / 2048.0f) + LN_EPS);
#pragma unroll
  for (int i = 0; i < 8; ++i) {
    int c = (lane + 64 * i) * 4;
    float4 gv = *(const float4*)(p.ln1_g + c), bv = *(const float4*)(p.ln1_b + c);
    float4 o = make_float4((v[i].x - mu) * rs * gv.x + bv.x, (v[i].y - mu) * rs * gv.y + bv.y, (v[i].z - mu) * rs * gv.z + bv.z, (v[i].w - mu) * rs * gv.w + bv.w);
    *(float4*)(yr + c) = o;
    *(uint2*)(p.YB + (size_t)row * 2048 + c) = make_uint2(pack2(o.x, o.y), pack2(o.z, o.w));
  }
}

DI void peer_select_item(const Params& p, int item, float* lds) {
  const int lane = threadIdx.x & 63, w = threadIdx.x >> 6;
  const int l15 = lane & 15, quad = lane >> 4;
  const int tile = item >> 1, h = (item & 1) * 4 + w;
  const int tok = tile * 16 + l15;
  const u16* qfr = p.PQ + (((size_t)tile * 16 + h * 2) * 4 * 64 + lane) * 8;
  float* lv = lds + w * 1536;
  int* li = (int*)(lv + 512);
  float* tvl = lv + 1024;
  int* el = (int*)(lv + 1280);
#pragma unroll 1
  for (int c = 0; c < 2; ++c) {
    bf16x8 bq[4];
#pragma unroll
    for (int ks = 0; ks < 4; ++ks) bq[ks] = ld8(qfr + (size_t)((c * 4 + ks) * 64) * 8);
    const u16* kb = p.PKEYS + ((size_t)(h * 2 + c) * 2048 + lane) * 8;
    int a[32];
#pragma unroll
    for (int kt = 0; kt < 8; ++kt) {
      f32x4 z = f32x4{0.f, 0.f, 0.f, 0.f};
#pragma unroll
      for (int ks = 0; ks < 4; ++ks) z = MFMA16(ld8(kb + (size_t)(kt * 4 + ks) * 512), bq[ks], z);
#pragma unroll
      for (int i = 0; i < 4; ++i) {
        const int b = __float_as_int(z[i]);
        const int k = b ^ ((b >> 31) & 0x7fffffff);
        a[kt * 4 + i] = (k & ~127) | (127 - (kt * 16 + quad * 4 + i));
      }
    }
#pragma unroll
    for (int k = 2; k <= 32; k <<= 1) {
#pragma unroll
      for (int j = k >> 1; j > 0; j >>= 1) {
#pragma unroll
        for (int i = 0; i < 32; ++i) {
          const int l = i ^ j;
          if (l > i) {
            const bool desc = ((i & k) == 0);
            const int hi = max(a[i], a[l]), lo = min(a[i], a[l]);
            a[i] = desc ? hi : lo; a[l] = desc ? lo : hi;
          }
        }
      }
    }
#pragma unroll 1
    for (int r = 0; r < 16; ++r) {
      const int bk = quad_maxi(a[0]);
      if (quad == 0) {
        const int kv = bk & ~127;
        lv[(c * 16 + r) * 16 + l15] = __int_as_float(kv ^ ((kv >> 31) & 0x7fffffff));
        li[(c * 16 + r) * 16 + l15] = 127 - (bk & 127);
      }
      const bool win = (a[0] == bk);
#pragma unroll
      for (int i = 0; i < 15; ++i) a[i] = win ? a[i + 1] : a[i];
      a[15] = win ? (int)0x80000000 : a[15];
    }
  }
  __syncthreads();
  float cv[13]; int cf[13];
#pragma unroll
  for (int k = 0; k < 13; ++k) {
    int a, bb; bool ok = true;
    if (k < 4) { a = 0; bb = k * 4 + quad; }
    else if (k < 6) { a = 1; bb = (k - 4) * 4 + quad; }
    else if (k == 6) { a = 2; bb = quad; }
    else if (k == 7) { a = 3; bb = quad; }
    else if (k == 8) { a = 8 + quad; bb = 0; }
    else if (k == 9) { a = 12 + quad; bb = 0; }
    else if (k == 10) { a = 4 + quad; bb = 0; }
    else if (k == 11) { a = 4 + quad; bb = 1; }
    else { a = (quad == 0) ? 2 : 4; bb = (quad == 0) ? 4 : 2; ok = quad < 2; }
    float v = lv[(0 * 16 + a) * 16 + l15] + lv[(1 * 16 + bb) * 16 + l15];
    cv[k] = ok ? v : -3.0e38f;
    cf[k] = ok ? (a * 16 + bb) : 999;
  }
  float tmax = 0.f, sum = 0.f;
#pragma unroll 1
  for (int r = 0; r < 16; ++r) {
    float bv = cv[0];
#pragma unroll
    for (int k = 1; k < 13; ++k) bv = fmaxf(bv, cv[k]);
    bv = quad_maxf(bv);
    int bi = 1000;
#pragma unroll
    for (int k = 0; k < 13; ++k) bi = (cv[k] == bv) ? min(bi, cf[k]) : bi;
    bi = quad_mini(bi);
    if (r == 0) tmax = bv;
    const float e = __expf(bv - tmax);
    sum += e;
    if (quad == 0) {
      const int a = bi >> 4, bb = bi & 15;
      el[r * 16 + l15] = li[(0 * 16 + a) * 16 + l15] * 128 + li[(1 * 16 + bb) * 16 + l15];
      tvl[r * 16 + l15] = e;
    }
#pragma unroll
    for (int k = 0; k < 13; ++k) cv[k] = (cf[k] == bi) ? -3.0e38f : cv[k];
  }
  __syncthreads();
  {
    const float isum = 1.0f / sum;
    int* ep = p.EIDX + (size_t)tok * 128 + h * 16 + quad * 4;
    float* gw = p.GW + (size_t)tok * 128 + h * 16 + quad * 4;
    const int r0 = quad * 4;
    *(int4*)ep = make_int4(el[(r0 + 0) * 16 + l15], el[(r0 + 1) * 16 + l15], el[(r0 + 2) * 16 + l15], el[(r0 + 3) * 16 + l15]);
    *(float4*)gw = make_float4(tvl[(r0 + 0) * 16 + l15] * isum, tvl[(r0 + 1) * 16 + l15] * isum, tvl[(r0 + 2) * 16 + l15] * isum, tvl[(r0 + 3) * 16 + l15] * isum);
  }
  __syncthreads();
}

#ifndef GB
#define GB 16
#endif
DI void peer_gather_item(const Params& p, int item, float* lds  ) {
  const int tid = threadIdx.x, lane = tid & 63, w = tid >> 6;
  const int tok = item * 4 + w;
  float* coef = lds + w * 128;
  int* idl = (int*)(lds + 512) + w * 128;
  const float* yrow = p.Y + (size_t)tok * 2048 + lane * 4;
  const int* eix = p.EIDX + (size_t)tok * 128;
  const float* gwp = p.GW + (size_t)tok * 128;
  const unsigned char* UBq = (const unsigned char*)p.UB;
  const unsigned char* VBq = (const unsigned char*)p.VB;
  idl[lane] = p.EIDX[(size_t)tok * 128 + lane]; idl[64 + lane] = p.EIDX[(size_t)tok * 128 + 64 + lane];
  float y[32];
#pragma unroll
  for (int j = 0; j < 8; ++j) {
    float4 a = *(const float4*)(yrow + j * 256);
    y[j * 4 + 0] = a.x; y[j * 4 + 1] = a.y; y[j * 4 + 2] = a.z; y[j * 4 + 3] = a.w;
  }
#pragma unroll 1
  for (int e8 = 0; e8 < 128; e8 += GB) {
    uint4 ra[GB]; uint2 rb[GB];
    int idx[GB];
#pragma unroll
    for (int u = 0; u < GB; ++u) {
      idx[u] = __builtin_amdgcn_readfirstlane(idl[e8 + u]);
      const unsigned char* up = UBq + (size_t)idx[u] * ROWB;
      ra[u] = *(const uint4*)(up + lane * 16);
      rb[u] = *(const uint2*)(up + 1024 + lane * 8);
    }
#pragma unroll
    for (int u = 0; u < GB; ++u) {
      const v6u q = {ra[u].x, ra[u].y, ra[u].z, ra[u].w, rb[u].x, rb[u].y};
      const v32f dv = __builtin_amdgcn_cvt_scalef32_pk32_f32_fp6(q, 1.0f);
      float d0 = 0.f, d1 = 0.f, d2 = 0.f, d3 = 0.f;
#pragma unroll
      for (int k = 0; k < 32; k += 4) { d0 += y[k] * dv[k]; d1 += y[k + 1] * dv[k + 1]; d2 += y[k + 2] * dv[k + 2]; d3 += y[k + 3] * dv[k + 3]; }
      float d = wave_sum((d0 + d1) + (d2 + d3)) * p.USC[idx[u]];
      if (lane == 0) coef[e8 + u] = gelu_tanh(d) * gwp[e8 + u] * p.VSC[idx[u]];
    }
  }
  float acc[32];
#pragma unroll
  for (int i = 0; i < 32; ++i) acc[i] = DN_ALPHA * y[i];
#pragma unroll 1
  for (int e8 = 0; e8 < 128; e8 += GB) {
    uint4 ra[GB]; uint2 rb[GB];
    float cf[GB];
#pragma unroll
    for (int u = 0; u < GB; ++u) {
      const int idx = __builtin_amdgcn_readfirstlane(idl[e8 + u]);
      cf[u] = coef[e8 + u];
      const unsigned char* vp = VBq + (size_t)idx * ROWB;
      ra[u] = *(const uint4*)(vp + lane * 16);
      rb[u] = *(const uint2*)(vp + 1024 + lane * 8);
    }
#pragma unroll
    for (int u = 0; u < GB; ++u) {
      const v6u q = {ra[u].x, ra[u].y, ra[u].z, ra[u].w, rb[u].x, rb[u].y};
      const v32f dv = __builtin_amdgcn_cvt_scalef32_pk32_f32_fp6(q, 1.0f);
#pragma unroll
      for (int k = 0; k < 32; ++k) acc[k] += cf[u] * dv[k];
    }
  }
  float s = 0.f;
#pragma unroll
  for (int i = 0; i < 32; ++i) s += acc[i];
  const float mu = wave_sum(s) * (1.0f / 2048.0f);
  float qv = 0.f;
#pragma unroll
  for (int i = 0; i < 32; ++i) { float d = acc[i] - mu; qv += d * d; }
  const float rs = rsqrtf(wave_sum(qv) * (1.0f / 2048.0f) + LN_EPS);
  float* op = p.out + (size_t)tok * 2048 + lane * 4;
#pragma unroll
  for (int j = 0; j < 8; ++j) {
    const float4 gv = *(const float4*)(p.ln2_g + j * 256 + lane * 4), bv = *(const float4*)(p.ln2_b + j * 256 + lane * 4);
    *(float4*)(op + j * 256) = make_float4((acc[j * 4 + 0] - mu) * rs * gv.x + bv.x, (acc[j * 4 + 1] - mu) * rs * gv.y + bv.y,
                                         (acc[j * 4 + 2] - mu) * rs * gv.z + bv.z, (acc[j * 4 + 3] - mu) * rs * gv.w + bv.w);
  }
}

constexpr int LDS_BYTES = 65536;
__global__ void __launch_bounds__(256, 2) mega(Params p) {
  __shared__ __attribute__((aligned(16))) unsigned char smem[LDS_BYTES];
  __shared__ uint4 xb_words;
  const int lo = (int)p.phase_lo, hi = (int)p.phase_hi;
  if (threadIdx.x == 0) xb_words = make_uint4(0u, 0u, 0u, 0u);
  __syncthreads();
  volatile LAS unsigned* const xst = (volatile LAS unsigned*)&xb_words;
  if (threadIdx.x == 0) (void)xb_add(&p.BAR[XB_XCNT(xb_xcc_id())], 1u);
  if (lo > 1000) cg::this_grid().sync();
#ifdef ONLY_PHASE
#define PH_ON(n) ((n) == ONLY_PHASE)
#else
#define PH_ON(n) true
#endif
#ifndef REP_MASK
#define REP_MASK 0
#endif
#define PH_BEGIN(n) if (PH_ON(n) && lo <= (n) && (n) < hi) { if ((n) > lo) xcd_barrier(p.BAR, xst); for (int rep_ = 0; rep_ < 1 + ((REP_MASK >> (n)) & 1); ++rep_) {
#define PH_END } }
  PH_BEGIN(0) phase_prep(p, (float*)smem); PH_END
  PH_BEGIN(1) phase_gemm1(p, (u16*)smem, xst); PH_END
  PH_BEGIN(2)
    for (int it = blockIdx.x; it < 128; it += gridDim.x) compress_item(p, it, (u16*)smem);
    for (;;) {
      if (threadIdx.x == 0) xst[2] = xb_add(&p.BAR[2], 1u);
      __syncthreads();
      const int k = (int)xst[2];
      __syncthreads();
      if (k >= NTOK / CT) break;
      conv_item(p, k, (float*)smem);
    }
  PH_END
  PH_BEGIN(3)
    if (blockIdx.x % 5 == 0) {
      const int nq = (gridDim.x + 4) / 5;
      for (int c = blockIdx.x / 5; c < 512; c += nq) {
        if (c < 256) quant_rows_fp6(p.pu, (unsigned char*)p.UB, p.USC, c * 64, 64);
        else         quant_rows_fp6(p.pv, (unsigned char*)p.VB, p.VSC, (c - 256) * 64, 64);
      }
      transpose_cvt(p.w_out, 2048, 2048, p.WOUTT, 2048, (float*)smem, blockIdx.x / 5, nq);
      transpose_cvt(p.wq, 2048, 2048, p.WQT, 2048, (float*)smem, blockIdx.x / 5, nq);
    }
    for (;;) {
      if (threadIdx.x == 0) xst[2] = xb_add(&p.BAR[1], 1u);
      __syncthreads();
      const int k = (int)xst[2];
      __syncthreads();
      if (k >= 2048) break;
      nsa_item(p, ((k & 7) << 8) | (255 - (k >> 3)), (float*)smem, smem + 16384);
    }
  PH_END
  PH_BEGIN(4) phase_gemm_mix(p, (u16*)smem); PH_END
  PH_BEGIN(5)
    for (int it = blockIdx.x; it < 2048; it += gridDim.x) ln1_item(p, it);
  PH_END
  PH_BEGIN(6) phase_gemm_pq(p, (u16*)smem); PH_END
  PH_BEGIN(7)
    for (int it = blockIdx.x; it < 1024; it += gridDim.x) peer_select_item(p, it, (float*)smem);
  PH_END
  PH_BEGIN(8)
    for (int it = blockIdx.x; it < NTOK / 4; it += gridDim.x) peer_gather_item(p, it, (float*)smem);
  PH_END
}

extern "C" void kernel_launch(void* const* d_in, const int* in_sizes, int n_in, void* d_out, int out_size,
                              void* d_ws, size_t ws_size, hipStream_t stream) {
  Params p{};
  const float** f = (const float**)&p;
  for (int i = 0; i < 21; ++i) f[i] = (const float*)d_in[i];
  p.out = (float*)d_out;
  unsigned char* ws = (unsigned char*)d_ws;
  size_t off = 0;
  auto take = [&](size_t bytes) { unsigned char* r = ws + off; off += (bytes + 255) & ~(size_t)255; return r; };
  p.XB = (u16*)take((size_t)NTOK * 2048 * 2);
  p.WINT = (u16*)take((size_t)HS * 2048 * 2);
  p.WOUTT = (u16*)take((size_t)2048 * 2048 * 2);
  p.WQT = (u16*)take((size_t)2048 * 2048 * 2);
  p.W1KT = (u16*)take((size_t)256 * 2048 * 2);
  p.W1VT = (u16*)take((size_t)256 * 2048 * 2);
  p.W2KT = (u16*)take((size_t)64 * 256 * 2);
  p.W2VT = (u16*)take((size_t)64 * 256 * 2);
  p.PKEYS = (u16*)take((size_t)8 * 2 * 128 * 128 * 2);
  p.UB = (u16*)take((size_t)16384 * ROWB);
  p.VB = (u16*)take((size_t)16384 * ROWB);
  p.USC = (float*)take(16384 * 4);
  p.VSC = (float*)take(16384 * 4);
  p.H = (u16*)take((size_t)NTOK * HS * 2);
  p.VT = (u16*)take((size_t)2 * 2 * 4 * 64 * 4096 * 2);
  p.KC = (u16*)take((size_t)8 * 256 * 64 * 2);
  p.VCT = (u16*)take((size_t)8 * 64 * 256 * 2);
  p.MIXB = (u16*)take((size_t)NTOK * 2048 * 2);
  p.BIAS = (float*)take(512 * 4);
  p.Y = (float*)take((size_t)NTOK * 2048 * 4);
  p.GW = (float*)take((size_t)NTOK * 128 * 4);
  p.EIDX = (int*)take((size_t)NTOK * 128 * 4);
  p.BAR = (unsigned*)take(XCD_BAR_WORDS * 4);
  p.YB = p.XB;
  p.PQ = p.MIXB;
  if (off > ws_size) { fprintf(stderr, "kernel_launch: workspace too small (%zu > %zu)\n", off, ws_size); return; }

  static int grid_blocks = 0;
  if (!grid_blocks) {
    int dev = 0, cus = 0, per_cu = 0;
    hipGetDevice(&dev);
    hipDeviceGetAttribute(&cus, hipDeviceAttributeMultiprocessorCount, dev);
    hipOccupancyMaxActiveBlocksPerMultiprocessor(&per_cu, mega, 256, 0);
    if (per_cu < 1) per_cu = 1;
    grid_blocks = cus * per_cu;
  }
  (void)hipMemsetAsync(p.BAR, 0, XCD_BAR_WORDS * 4, stream);
#if N_LAUNCH_MODE == 1
  p.phase_lo = 0; p.phase_hi = NPHASE;
  void* args[] = {&p};
  hipError_t e = hipLaunchCooperativeKernel((void*)mega, dim3(grid_blocks), dim3(256), args, 0, stream);
  if (e != hipSuccess) fprintf(stderr, "cooperative launch failed: %s (grid %d)\n", hipGetErrorString(e), grid_blocks);
#else
  for (int ph = 0; ph < NPHASE; ++ph) {
    p.phase_lo = ph; p.phase_hi = ph + 1;
    hipLaunchKernelGGL(mega, dim3(grid_blocks), dim3(256), 0, stream, p);
  }
#endif
}
```

```cpp
#include <hip/hip_runtime.h>
#include <hip/hip_cooperative_groups.h>
#include <cstdio>
namespace cg = cooperative_groups;

typedef unsigned short u16;
typedef unsigned long long u64;
using bf16x8 = __attribute__((ext_vector_type(8))) short;
using f32x4  = __attribute__((ext_vector_type(4))) float;
#define DI __device__ __forceinline__
#define MFMA16(a, b, c) __builtin_amdgcn_mfma_f32_16x16x32_bf16((a), (b), (c), 0, 0, 0)

#ifndef N_LAUNCH_MODE
#define N_LAUNCH_MODE 1
#endif

constexpr int D_MODEL = 2048, SEQ = 4096, NTOK = 8192;
constexpr int D_IN = 4656, HS = 4736;
constexpr int COL_KV = 1024, COL_GATE = 2560, COL_CONV = 2608;
constexpr float DN_ALPHA = 1.189207115002721f;
constexpr float LN_EPS = 1e-5f;
constexpr int NPHASE = 9;

struct Params {
  const float *x, *w_in, *pos_k, *w1_k, *w2_k, *pos_v, *w1_v, *w2_v, *dw_w, *dw_b, *cln_g, *cln_b,
      *w_out, *ln1_g, *ln1_b, *wq, *pkeys, *pu, *pv, *ln2_g, *ln2_b;
  float* out;
  u16 *XB, *WINT, *WOUTT, *WQT, *W1KT, *W1VT, *W2KT, *W2VT, *PKEYS, *UB, *VB, *H, *VT, *KC, *VCT, *MIXB, *YB, *PQ;
  float *BIAS, *Y, *GW, *USC, *VSC;
  int* EIDX;
  unsigned* BAR;
  long long phase_lo, phase_hi;
};

typedef __bf16 bf16x2_hw __attribute__((ext_vector_type(2)));
typedef float f32x2_hw __attribute__((ext_vector_type(2)));
DI unsigned pack2(float lo, float hi) {
  const f32x2_hw v = {lo, hi};
  return __builtin_bit_cast(unsigned, __builtin_convertvector(v, bf16x2_hw));
}
DI u16 f2bf(float x) { return (u16)(pack2(x, 0.f) & 0xffffu); }
DI float bf2f(u16 b) { return __uint_as_float(((unsigned)b) << 16); }
DI float bflo(unsigned u) { return __uint_as_float(u << 16); }
DI float bfhi(unsigned u) { return __uint_as_float(u & 0xffff0000u); }
DI float sigmoidf_(float x) { return __builtin_amdgcn_rcpf(1.0f + __expf(-x)); }
DI float gelu_tanh(float x) {
  float z = 0.7978845608028654f * (x + 0.044715f * x * x * x);
  float t = 1.0f - 2.0f * __builtin_amdgcn_rcpf(__expf(2.0f * z) + 1.0f);
  return 0.5f * x * (1.0f + t);
}
DI float q16f(float v, bool sum) {
  auto r = __builtin_amdgcn_permlane16_swap(__float_as_uint(v), __float_as_uint(v), false, false);
  const float a = __uint_as_float(r[0]), b = __uint_as_float(r[1]);
  return sum ? a + b : fmaxf(a, b);
}
DI float q32f(float v, bool sum) {
  auto r = __builtin_amdgcn_permlane32_swap(__float_as_uint(v), __float_as_uint(v), false, false);
  const float a = __uint_as_float(r[0]), b = __uint_as_float(r[1]);
  return sum ? a + b : fmaxf(a, b);
}
DI float quad_maxf(float v) { return q32f(q16f(v, false), false); }
DI float quad_sumf(float v) { return q32f(q16f(v, true), true); }
DI int quad_maxi(int v) {
  auto r = __builtin_amdgcn_permlane16_swap((unsigned)v, (unsigned)v, false, false);
  v = max((int)r[0], (int)r[1]);
  auto s = __builtin_amdgcn_permlane32_swap((unsigned)v, (unsigned)v, false, false);
  return max((int)s[0], (int)s[1]);
}
DI int quad_mini(int v) {
  auto r = __builtin_amdgcn_permlane16_swap((unsigned)v, (unsigned)v, false, false);
  v = min((int)r[0], (int)r[1]);
  auto s = __builtin_amdgcn_permlane32_swap((unsigned)v, (unsigned)v, false, false);
  return min((int)s[0], (int)s[1]);
}
template <int CTRL> DI float dppf(float v) { return __int_as_float(__builtin_amdgcn_update_dpp(0, __float_as_int(v), CTRL, 0xf, 0xf, false)); }
DI float wave_sum(float v) {
  v += dppf<0xB1>(v);
  v += dppf<0x4E>(v);
  v += dppf<0x141>(v);
  v += dppf<0x140>(v);
  return quad_sumf(v);
}
template <int CTRL> DI unsigned dppu(unsigned v) { return (unsigned)__builtin_amdgcn_update_dpp(0, (int)v, CTRL, 0xf, 0xf, false); }
DI float wave_max(float v) {
  v = fmaxf(v, dppf<0xB1>(v)); v = fmaxf(v, dppf<0x4E>(v)); v = fmaxf(v, dppf<0x141>(v)); v = fmaxf(v, dppf<0x140>(v));
  return quad_maxf(v);
}
DI unsigned row_or(unsigned v) {
  v |= dppu<0xB1>(v); v |= dppu<0x4E>(v); v |= dppu<0x141>(v); v |= dppu<0x140>(v);
  return v;
}
DI float block_sum(float v, float* red) {
  v = wave_sum(v);
  if ((threadIdx.x & 63) == 0) red[threadIdx.x >> 6] = v;
  __syncthreads();
  float r = red[0] + red[1] + red[2] + red[3];
  __syncthreads();
  return r;
}
DI bf16x8 ld8(const u16* p) { return *(const bf16x8*)p; }
DI bf16x8 comb(uint2 lo, uint2 hi) {
  uint4 v = make_uint4(lo.x, lo.y, hi.x, hi.y);
  return __builtin_bit_cast(bf16x8, v);
}
DI bf16x8 packp(f32x4 a, f32x4 b) {
  uint4 v = make_uint4(pack2(a[0], a[1]), pack2(a[2], a[3]), pack2(b[0], b[1]), pack2(b[2], b[3]));
  return __builtin_bit_cast(bf16x8, v);
}

#define XB_TMO      128
#define XB_XCNT(j)  (256  + 64 * (j))
#define XB_XSUB(j)  (1280 + 64 * (j))
#define XB_XGEN(j)  (2304 + 64 * (j))
#define XB_TOP      3328
#define XB_TOPGEN   3392
#define XCD_BAR_WORDS 3456
#define XB_SPIN_CAP (1u << 22)
#define LAS __attribute__((address_space(3)))
DI unsigned xb_ld(unsigned* p)              { return __hip_atomic_load(p, __ATOMIC_RELAXED, __HIP_MEMORY_SCOPE_AGENT); }
DI unsigned xb_add(unsigned* p, unsigned v) { return __hip_atomic_fetch_add(p, v, __ATOMIC_RELAXED, __HIP_MEMORY_SCOPE_AGENT); }
DI unsigned xb_xcc_id() { return (unsigned)__builtin_amdgcn_s_getreg((3 << 11) | 20) & 0xFu; }
#define XB_SPIN(cond, bar) do { unsigned _sp = 0; while (cond) { __builtin_amdgcn_s_sleep(1); \
    if ((++_sp & 255u) == 0u) { if (xb_ld(&(bar)[XB_TMO])) break; if (_sp > XB_SPIN_CAP) { (void)xb_add(&(bar)[XB_TMO], 1u); break; } } } } while (0)
struct XcdBarrier { unsigned* bar; unsigned x; volatile LAS unsigned* st; };
DI XcdBarrier xcd_barrier_post(unsigned* bar, volatile LAS unsigned* st) {
  XcdBarrier b; b.bar = bar; b.x = xb_xcc_id(); b.st = st;
  if (threadIdx.x == 0) (void)xb_add(&bar[XB_XCNT(b.x)], 1u);
  return b;
}
DI void xcd_barrier_complete(unsigned* bar, unsigned x, unsigned& nloc, unsigned& nx) {
  const unsigned G = gridDim.x * gridDim.y * gridDim.z;
  unsigned sum, cnt, mine, sp = 0u;
  for (;;) {
    sum = 0u; cnt = 0u; mine = 0u;
#pragma unroll 1
    for (unsigned j = 0; j < 16; ++j) { const unsigned c = xb_ld(&bar[XB_XCNT(j)]); sum += c; cnt += (c > 0u) ? 1u : 0u; mine = (j == x) ? c : mine; }
    if (sum == G) break;
    __builtin_amdgcn_s_sleep(1);
    if ((++sp & 255u) == 0u) { if (xb_ld(&bar[XB_TMO])) break; if (sp > XB_SPIN_CAP) { (void)xb_add(&bar[XB_TMO], 1u); break; } }
  }
  nloc = mine > 0u ? mine : 1u; nx = cnt > 0u ? cnt : 1u;
}
DI void xcd_barrier(unsigned* const bar, volatile LAS unsigned* const bst) {
  const unsigned bx = xb_xcc_id();
  asm volatile("s_waitcnt vmcnt(0)" ::: "memory");
  __syncthreads();
  if (threadIdx.x == 0) {
    __builtin_amdgcn_s_waitcnt(0);
    unsigned nloc = bst[0], nx = bst[1];
    if (nloc == 0u) { xcd_barrier_complete(bar, bx, nloc, nx); bst[0] = nloc; bst[1] = nx; }
    const unsigned old = xb_add(&bar[XB_XSUB(bx)], 1u);
    const unsigned gen = old / nloc;
    if (old + 1u == (gen + 1u) * nloc) {
      __builtin_amdgcn_fence(__ATOMIC_RELEASE, "agent");
      asm volatile("s_waitcnt vmcnt(0)" ::: "memory");
      const unsigned og = xb_add(&bar[XB_TOP], 1u);
      const unsigned tg = og / nx;
      if (og + 1u == (tg + 1u) * nx) xb_add(&bar[XB_TOPGEN], 1u);
      else XB_SPIN(xb_ld(&bar[XB_TOPGEN]) == tg, bar);
      __builtin_amdgcn_fence(__ATOMIC_ACQUIRE, "agent");
      xb_add(&bar[XB_XGEN(bx)], 1u);
      asm volatile("s_waitcnt vmcnt(0)" ::: "memory");
    } else {
      XB_SPIN(xb_ld(&bar[XB_XGEN(bx)]) == gen, bar);
      __builtin_amdgcn_fence(__ATOMIC_ACQUIRE, "agent");
      asm volatile("s_waitcnt vmcnt(0)" ::: "memory");
    }
  }
  __syncthreads();
}

DI void cvt_f32_bf16(const float* __restrict__ src, u16* __restrict__ dst, size_t n8) {
  size_t i = (size_t)blockIdx.x * 256 + threadIdx.x, stride = (size_t)gridDim.x * 256;
  for (; i < n8; i += stride) {
    float4 a = ((const float4*)src)[2 * i], b = ((const float4*)src)[2 * i + 1];
    uint4 o = make_uint4(pack2(a.x, a.y), pack2(a.z, a.w), pack2(b.x, b.y), pack2(b.z, b.w));
    ((uint4*)dst)[i] = o;
  }
}
DI void transpose_cvt(const float* __restrict__ src, int R, int C, u16* __restrict__ dst, int Cpad, float* tile, int bid, int nb) {
  const int tid = threadIdx.x;
  const int tr = R / 64, tc = Cpad / 64;
  for (int it = bid; it < tr * tc; it += nb) {
    const int r0 = (it / tc) * 64, c0 = (it % tc) * 64;
#pragma unroll
    for (int ps = 0; ps < 4; ++ps) {
      int r = ps * 16 + (tid >> 4), c = (tid & 15) * 4;
      float4 v = make_float4(0.f, 0.f, 0.f, 0.f);
      if (c0 + c < C) v = *(const float4*)(src + (size_t)(r0 + r) * C + c0 + c);
      tile[(c + 0) * 65 + r] = v.x; tile[(c + 1) * 65 + r] = v.y; tile[(c + 2) * 65 + r] = v.z; tile[(c + 3) * 65 + r] = v.w;
    }
    __syncthreads();
    {
      int c = tid >> 2, part = tid & 3;
      const float* tp = tile + c * 65 + part * 16;
      uint4 o0 = make_uint4(pack2(tp[0], tp[1]), pack2(tp[2], tp[3]), pack2(tp[4], tp[5]), pack2(tp[6], tp[7]));
      uint4 o1 = make_uint4(pack2(tp[8], tp[9]), pack2(tp[10], tp[11]), pack2(tp[12], tp[13]), pack2(tp[14], tp[15]));
      uint4* dp = (uint4*)(dst + (size_t)(c0 + c) * R + r0 + part * 16);
      dp[0] = o0; dp[1] = o1;
    }
    __syncthreads();
  }
}

typedef float v32f __attribute__((ext_vector_type(32)));
typedef _Float16 v32h __attribute__((ext_vector_type(32)));
typedef unsigned v6u __attribute__((ext_vector_type(6)));
constexpr int ROWB = 1536;
DI void quant_rows_fp6(const float* __restrict__ src, unsigned char* __restrict__ dst, float* __restrict__ sc, int row0, int nrows) {
  const int lane = threadIdx.x & 63;
  for (int row = row0 + (threadIdx.x >> 6); row < row0 + nrows; row += 4) {
    const float* sp = src + (size_t)row * 2048 + lane * 4;
    float4 v[8];
    float am = 0.f;
#pragma unroll
    for (int j = 0; j < 8; ++j) {
      float4 t = *(const float4*)(sp + j * 256);
      v[j] = t;
      am = fmaxf(am, fmaxf(fmaxf(fabsf(t.x), fabsf(t.y)), fmaxf(fabsf(t.z), fabsf(t.w))));
    }
    am = wave_max(am);
    const float scale = am > 0.f ? 7.0f / am : 1.0f;
    if (lane == 0) sc[row] = am > 0.f ? am * (1.0f / 7.0f) : 1.0f;
    v32h h;
#pragma unroll
    for (int j = 0; j < 8; ++j) {
      h[j * 4 + 0] = (_Float16)(v[j].x * scale); h[j * 4 + 1] = (_Float16)(v[j].y * scale);
      h[j * 4 + 2] = (_Float16)(v[j].z * scale); h[j * 4 + 3] = (_Float16)(v[j].w * scale);
    }
    const v6u q = __builtin_amdgcn_cvt_scalef32_pk32_fp6_f16(h, 1.0f);
    unsigned char* dp = dst + (size_t)row * ROWB;
    *(uint4*)(dp + lane * 16) = make_uint4(q[0], q[1], q[2], q[3]);
    *(uint2*)(dp + 1024 + lane * 8) = make_uint2(q[4], q[5]);
  }
}

DI void phase_prep(const Params& p, float* lds) {
  cvt_f32_bf16(p.x, p.XB, (size_t)NTOK * D_MODEL / 8);
  for (int o = blockIdx.x * 256 + threadIdx.x; o < 16 * 8 * 4 * 64; o += gridDim.x * 256) {
    const int ln = o & 63, ks = (o >> 6) & 3, kt = (o >> 8) & 7, hc = o >> 11;
    const float* ksrc = p.pkeys + ((size_t)(hc * 128 + kt * 16 + (ln & 15))) * 128 + ks * 32 + (ln >> 4) * 8;
    const float4 a = *(const float4*)ksrc, b = *(const float4*)(ksrc + 4);
    *(uint4*)(p.PKEYS + (size_t)o * 8) = make_uint4(pack2(a.x, a.y), pack2(a.z, a.w), pack2(b.x, b.y), pack2(b.z, b.w));
  }
  transpose_cvt(p.w_in, 2048, D_IN, p.WINT, HS, lds, blockIdx.x, gridDim.x);
  for (int o = blockIdx.x * 256 + threadIdx.x; o < 2 * 65536; o += gridDim.x * 256) {
    const int kind = o >> 16, r = o & 65535;
    const int ln = r & 63, t = (r >> 6) & 15, ks = r >> 10;
    const float* wsrc = (kind ? p.w1_v : p.w1_k) + (size_t)(ks * 32 + (ln >> 4) * 8) * 256 + t * 16 + (ln & 15);
    uint4 v = make_uint4(pack2(wsrc[0], wsrc[256]), pack2(wsrc[512], wsrc[768]), pack2(wsrc[1024], wsrc[1280]), pack2(wsrc[1536], wsrc[1792]));
    *(uint4*)((kind ? p.W1VT : p.W1KT) + (size_t)r * 8) = v;
  }
  transpose_cvt(p.w2_k, 256, 64, p.W2KT, 64, lds, blockIdx.x, gridDim.x);
  transpose_cvt(p.w2_v, 256, 64, p.W2VT, 64, lds, blockIdx.x, gridDim.x);
}

constexpr int LDS_ROW = 72;
template <class Epi>
DI void gemm_tile(const u16* __restrict__ P, int ldp, const u16* __restrict__ Q, int ldq, int K,
                          int p0, int q0, u16* lds, Epi epi) {
  const int tid = threadIdx.x, lane = tid & 63, w = tid >> 6;
  const int wp = w & 1, wq = w >> 1;
  const int l15 = lane & 15, quad = lane >> 4;
  u16* sP = lds;
  u16* sQ = lds + 128 * LDS_ROW;
  f32x4 acc[4][4];
#pragma unroll
  for (int i = 0; i < 4; ++i)
#pragma unroll
    for (int j = 0; j < 4; ++j) acc[i][j] = f32x4{0.f, 0.f, 0.f, 0.f};
  const int srow = tid >> 3, scc = tid & 7;
  const u16* gp = P + (size_t)(p0 + srow) * ldp + scc * 8;
  const u16* gq = Q + (size_t)(q0 + srow) * ldq + scc * 8;
  const u16* gp1 = gp + (size_t)32 * ldp; const u16* gp2 = gp + (size_t)64 * ldp; const u16* gp3 = gp + (size_t)96 * ldp;
  const u16* gq1 = gq + (size_t)32 * ldq; const u16* gq2 = gq + (size_t)64 * ldq; const u16* gq3 = gq + (size_t)96 * ldq;
  uint4 rp0 = *(const uint4*)gp, rp1 = *(const uint4*)gp1, rp2 = *(const uint4*)gp2, rp3 = *(const uint4*)gp3;
  uint4 rq0 = *(const uint4*)gq, rq1 = *(const uint4*)gq1, rq2 = *(const uint4*)gq2, rq3 = *(const uint4*)gq3;
  uint4 sp0 = *(const uint4*)(gp + 64), sp1 = *(const uint4*)(gp1 + 64), sp2 = *(const uint4*)(gp2 + 64), sp3 = *(const uint4*)(gp3 + 64);
  uint4 sq0 = *(const uint4*)(gq + 64), sq1 = *(const uint4*)(gq1 + 64), sq2 = *(const uint4*)(gq2 + 64), sq3 = *(const uint4*)(gq3 + 64);
  u16* wP = sP + srow * LDS_ROW + scc * 8;
  u16* wQ = sQ + srow * LDS_ROW + scc * 8;
  const int nkt = K / 64;
#define GEMM_COMPUTE() \
  _Pragma("unroll") for (int ks = 0; ks < 2; ++ks) { \
    bf16x8 a[4], b[4]; \
    _Pragma("unroll") for (int i = 0; i < 4; ++i) { \
      a[i] = *(const bf16x8*)(sP + (wp * 64 + i * 16 + l15) * LDS_ROW + ks * 32 + quad * 8); \
      b[i] = *(const bf16x8*)(sQ + (wq * 64 + i * 16 + l15) * LDS_ROW + ks * 32 + quad * 8); } \
    _Pragma("unroll") for (int i = 0; i < 4; ++i) \
      _Pragma("unroll") for (int j = 0; j < 4; ++j) acc[i][j] = MFMA16(a[i], b[j], acc[i][j]); }
  for (int kt = 0; kt < nkt; kt += 2) {
    *(uint4*)(wP) = rp0; *(uint4*)(wP + 32 * LDS_ROW) = rp1; *(uint4*)(wP + 64 * LDS_ROW) = rp2; *(uint4*)(wP + 96 * LDS_ROW) = rp3;
    *(uint4*)(wQ) = rq0; *(uint4*)(wQ + 32 * LDS_ROW) = rq1; *(uint4*)(wQ + 64 * LDS_ROW) = rq2; *(uint4*)(wQ + 96 * LDS_ROW) = rq3;
    __syncthreads();
    if (kt + 2 < nkt) {
      const int ko = (kt + 2) * 64;
      rp0 = *(const uint4*)(gp + ko); rp1 = *(const uint4*)(gp1 + ko); rp2 = *(const uint4*)(gp2 + ko); rp3 = *(const uint4*)(gp3 + ko);
      rq0 = *(const uint4*)(gq + ko); rq1 = *(const uint4*)(gq1 + ko); rq2 = *(const uint4*)(gq2 + ko); rq3 = *(const uint4*)(gq3 + ko);
    }
    GEMM_COMPUTE()
    __syncthreads();
    *(uint4*)(wP) = sp0; *(uint4*)(wP + 32 * LDS_ROW) = sp1; *(uint4*)(wP + 64 * LDS_ROW) = sp2; *(uint4*)(wP + 96 * LDS_ROW) = sp3;
    *(uint4*)(wQ) = sq0; *(uint4*)(wQ + 32 * LDS_ROW) = sq1; *(uint4*)(wQ + 64 * LDS_ROW) = sq2; *(uint4*)(wQ + 96 * LDS_ROW) = sq3;
    __syncthreads();
    if (kt + 3 < nkt) {
      const int ko = (kt + 3) * 64;
      sp0 = *(const uint4*)(gp + ko); sp1 = *(const uint4*)(gp1 + ko); sp2 = *(const uint4*)(gp2 + ko); sp3 = *(const uint4*)(gp3 + ko);
      sq0 = *(const uint4*)(gq + ko); sq1 = *(const uint4*)(gq1 + ko); sq2 = *(const uint4*)(gq2 + ko); sq3 = *(const uint4*)(gq3 + ko);
    }
    GEMM_COMPUTE()
    __syncthreads();
  }
#undef GEMM_COMPUTE
#pragma unroll
  for (int i = 0; i < 4; ++i)
#pragma unroll
    for (int j = 0; j < 4; ++j)
      epi(p0 + wp * 64 + i * 16 + quad * 4, q0 + wq * 64 + j * 16 + l15, acc[i][j]);
}

template <class Epi>
DI void gemm_tile_big(const u16* __restrict__ P, int ldp, const u16* __restrict__ Q, int ldq, int K,
                      int p0, int q0, u16* lds, Epi epi) {
  const int tid = threadIdx.x, lane = tid & 63, w = tid >> 6;
  const int wp = w & 1, wq = w >> 1;
  const int l15 = lane & 15, quad = lane >> 4;
  u16* sP = lds;
  u16* sQ = lds + 128 * LDS_ROW;
  f32x4 acc[4][8];
#pragma unroll
  for (int i = 0; i < 4; ++i)
#pragma unroll
    for (int j = 0; j < 8; ++j) acc[i][j] = f32x4{0.f, 0.f, 0.f, 0.f};
  const int srow = tid >> 3, scc = tid & 7;
  const u16* gp = P + (size_t)(p0 + srow) * ldp + scc * 8;
  const u16* gq = Q + (size_t)(q0 + srow) * ldq + scc * 8;
  const size_t sp32 = (size_t)32 * ldp, sq32 = (size_t)32 * ldq;
  uint4 rp0 = *(const uint4*)gp, rp1 = *(const uint4*)(gp + sp32), rp2 = *(const uint4*)(gp + 2 * sp32), rp3 = *(const uint4*)(gp + 3 * sp32);
  uint4 rq0 = *(const uint4*)gq, rq1 = *(const uint4*)(gq + sq32), rq2 = *(const uint4*)(gq + 2 * sq32), rq3 = *(const uint4*)(gq + 3 * sq32);
  uint4 rq4 = *(const uint4*)(gq + 4 * sq32), rq5 = *(const uint4*)(gq + 5 * sq32), rq6 = *(const uint4*)(gq + 6 * sq32), rq7 = *(const uint4*)(gq + 7 * sq32);
  u16* wP = sP + srow * LDS_ROW + scc * 8;
  u16* wQ = sQ + srow * LDS_ROW + scc * 8;
  const int nkt = K / 64;
  for (int kt = 0; kt < nkt; ++kt) {
    *(uint4*)(wP) = rp0; *(uint4*)(wP + 32 * LDS_ROW) = rp1; *(uint4*)(wP + 64 * LDS_ROW) = rp2; *(uint4*)(wP + 96 * LDS_ROW) = rp3;
    *(uint4*)(wQ) = rq0; *(uint4*)(wQ + 32 * LDS_ROW) = rq1; *(uint4*)(wQ + 64 * LDS_ROW) = rq2; *(uint4*)(wQ + 96 * LDS_ROW) = rq3;
    *(uint4*)(wQ + 128 * LDS_ROW) = rq4; *(uint4*)(wQ + 160 * LDS_ROW) = rq5; *(uint4*)(wQ + 192 * LDS_ROW) = rq6; *(uint4*)(wQ + 224 * LDS_ROW) = rq7;
    __syncthreads();
    if (kt + 1 < nkt) {
      const int ko = (kt + 1) * 64;
      rp0 = *(const uint4*)(gp + ko); rp1 = *(const uint4*)(gp + sp32 + ko); rp2 = *(const uint4*)(gp + 2 * sp32 + ko); rp3 = *(const uint4*)(gp + 3 * sp32 + ko);
      rq0 = *(const uint4*)(gq + ko); rq1 = *(const uint4*)(gq + sq32 + ko); rq2 = *(const uint4*)(gq + 2 * sq32 + ko); rq3 = *(const uint4*)(gq + 3 * sq32 + ko);
      rq4 = *(const uint4*)(gq + 4 * sq32 + ko); rq5 = *(const uint4*)(gq + 5 * sq32 + ko); rq6 = *(const uint4*)(gq + 6 * sq32 + ko); rq7 = *(const uint4*)(gq + 7 * sq32 + ko);
    }
    {
#define LDA_(dst, ks) _Pragma("unroll") for (int i = 0; i < 4; ++i) dst[i] = *(const bf16x8*)(sP + (wp * 64 + i * 16 + l15) * LDS_ROW + (ks) * 32 + quad * 8)
#define LDB_(dst, ks, jh) _Pragma("unroll") for (int j = 0; j < 4; ++j) dst[j] = *(const bf16x8*)(sQ + (wq * 128 + ((jh) * 4 + j) * 16 + l15) * LDS_ROW + (ks) * 32 + quad * 8)
#define MM_(a, b, jh) do { __builtin_amdgcn_s_setprio(1); _Pragma("unroll") for (int i = 0; i < 4; ++i) _Pragma("unroll") for (int j = 0; j < 4; ++j) acc[i][(jh) * 4 + j] = MFMA16(a[i], b[j], acc[i][(jh) * 4 + j]); __builtin_amdgcn_s_setprio(0); } while (0)
#define SCHED_ __builtin_amdgcn_sched_barrier(0)
      bf16x8 a[4], b0[4], b1[4];
      LDA_(a, 0); LDB_(b0, 0, 0); LDB_(b1, 0, 1);
      SCHED_;
      MM_(a, b0, 0);
      SCHED_;
      LDB_(b0, 1, 0);
      SCHED_;
      MM_(a, b1, 1);
      SCHED_;
      LDA_(a, 1); LDB_(b1, 1, 1);
      SCHED_;
      MM_(a, b0, 0);
      SCHED_;
      MM_(a, b1, 1);
#undef LDA_
#undef LDB_
#undef MM_
#undef SCHED_
    }
    __syncthreads();
  }
#pragma unroll
  for (int i = 0; i < 4; ++i)
#pragma unroll
    for (int j = 0; j < 8; ++j)
      epi(p0 + wp * 64 + i * 16 + quad * 4, q0 + wq * 128 + j * 16 + l15, acc[i][j]);
}

template <class Epi>
DI void gemm_tile_glds(const u16* __restrict__ P, int ldp, const u16* __restrict__ Q, int ldq, int K,
                       int p0, int q0, unsigned char* lds, Epi epi) {
  const int tid = threadIdx.x, lane = tid & 63, w = tid >> 6;
  const int wp = w & 1, wq = w >> 1;
  const int l15 = lane & 15, quad = lane >> 4;
  f32x4 acc[4][4];
#pragma unroll
  for (int i = 0; i < 4; ++i)
#pragma unroll
    for (int j = 0; j < 4; ++j) acc[i][j] = f32x4{0.f, 0.f, 0.f, 0.f};
  const int srow = w * 8 + (lane >> 3);
  const int csrc = (lane & 7) ^ ((srow >> 1) & 7);
  const u16* gp = P + (size_t)(p0 + srow) * ldp + csrc * 8;
  const u16* gq = Q + (size_t)(q0 + srow) * ldq + csrc * 8;
  const unsigned dP = (unsigned)__builtin_amdgcn_readfirstlane((int)(unsigned)(size_t)(lds + (w * 8) * 128));
  const unsigned dQ = dP + 16384u;
#define GLDS16(gsrc_, ldsb_) do { unsigned keep_; \
    asm volatile("s_mov_b32 %0, m0\n\ts_mov_b32 m0, %2\n\ts_nop 0\n\tglobal_load_lds_dwordx4 %1, off\n\ts_mov_b32 m0, %0" \
                 : "=&s"(keep_) : "v"(gsrc_), "s"(ldsb_) : "memory"); } while (0)
#define GLDS_ISSUE(kt_, buf_) do { \
    _Pragma("unroll") for (int j = 0; j < 4; ++j) { \
      GLDS16(gp + (size_t)(32 * j) * ldp + (kt_) * 64, dP + (unsigned)(j * 4096 + (buf_) * 32768)); \
      GLDS16(gq + (size_t)(32 * j) * ldq + (kt_) * 64, dQ + (unsigned)(j * 4096 + (buf_) * 32768)); } } while (0)
  GLDS_ISSUE(0, 0);
  const int nkt = K / 64;
  const int sw = l15 >> 1;
  const unsigned char* rP = lds + (wp * 64 + l15) * 128;
  const unsigned char* rQ = lds + 16384 + (wq * 64 + l15) * 128;
  for (int kt = 0; kt < nkt; ++kt) {
    asm volatile("s_waitcnt vmcnt(0)" ::: "memory");
    __builtin_amdgcn_s_barrier();
    if (kt + 1 < nkt) GLDS_ISSUE(kt + 1, (kt + 1) & 1);
    const int bo = (kt & 1) * 32768;
#pragma unroll
    for (int ks = 0; ks < 2; ++ks) {
      const int co = ((ks * 4 + quad) ^ sw) * 16;
      bf16x8 a[4], b[4];
#pragma unroll
      for (int i = 0; i < 4; ++i) {
        a[i] = *(const bf16x8*)(rP + bo + i * 2048 + co);
        b[i] = *(const bf16x8*)(rQ + bo + i * 2048 + co);
      }
#pragma unroll
      for (int i = 0; i < 4; ++i)
#pragma unroll
        for (int j = 0; j < 4; ++j) acc[i][j] = MFMA16(a[i], b[j], acc[i][j]);
    }
  }
#undef GLDS_ISSUE
#undef GLDS16
  __syncthreads();
  if constexpr (Epi::kPairRows) {
#pragma unroll
    for (int j = 0; j < 4; ++j)
#pragma unroll
      for (int i = 0; i < 4; i += 2) {
        const unsigned alo = pack2(acc[i][j][0], acc[i][j][1]), ahi = pack2(acc[i][j][2], acc[i][j][3]);
        const unsigned blo = pack2(acc[i + 1][j][0], acc[i + 1][j][1]), bhi = pack2(acc[i + 1][j][2], acc[i + 1][j][3]);
        auto rl = __builtin_amdgcn_permlane16_swap(alo, blo, false, false);
        auto rh = __builtin_amdgcn_permlane16_swap(ahi, bhi, false, false);
        epi.store8(p0 + wp * 64 + (i + (quad & 1)) * 16 + (quad >> 1) * 8, q0 + wq * 64 + j * 16 + l15, make_uint4(rl[0], rh[0], rl[1], rh[1]));
      }
  } else {
#pragma unroll
    for (int i = 0; i < 4; ++i)
#pragma unroll
      for (int j = 0; j < 4; ++j)
        epi(p0 + wp * 64 + i * 16 + quad * 4, q0 + wq * 64 + j * 16 + l15, acc[i][j]);
  }
}

struct EpiH {
  static constexpr bool kPairRows = true;
  u16* H;
  DI void store8(int pch, int tok, uint4 v) const { *(uint4*)(H + (size_t)tok * HS + pch) = v; }
  DI void operator()(int pch, int tok, f32x4 v) const {
    *(uint2*)(H + (size_t)tok * HS + pch) = make_uint2(pack2(v[0], v[1]), pack2(v[2], v[3]));
  }
};
struct EpiVT {
  static constexpr bool kPairRows = false;
  u16* VT;
  DI void operator()(int tok, int ch, f32x4 v) const {
    int which = (ch >= 2304) ? 1 : 0;
    int cc = ch & 255;
    int g = cc >> 6, d = cc & 63;
    int b = tok >> 12, t = tok & 4095;
    *(uint2*)(VT + ((size_t)((which * 2 + b) * 4 + g) * 64 + d) * 4096 + t) = make_uint2(pack2(v[0], v[1]), pack2(v[2], v[3]));
  }
};
struct EpiMix {
  static constexpr bool kPairRows = false;
  float* Y; const float* x;
  DI void operator()(int c, int tok, f32x4 v) const {
    float4 xv = *(const float4*)(x + (size_t)tok * 2048 + c);
    *(float4*)(Y + (size_t)tok * 2048 + c) = make_float4(DN_ALPHA * xv.x + v[0], DN_ALPHA * xv.y + v[1], DN_ALPHA * xv.z + v[2], DN_ALPHA * xv.w + v[3]);
  }
};
struct EpiPQ {
  static constexpr bool kPairRows = false;
  u16* PQ;
  DI void operator()(int c, int tok, f32x4 v) const {
    const size_t off = ((((size_t)(tok >> 4) * 16 + (c >> 7)) * 4 + ((c >> 5) & 3)) * 64 + ((c >> 3) & 3) * 16 + (tok & 15)) * 8 + (c & 7);
    *(uint2*)(PQ + off) = make_uint2(pack2(v[0], v[1]), pack2(v[2], v[3]));
  }
};

DI void phase_gemm1(const Params& p, u16* lds, volatile LAS unsigned* bcast) {
  for (;;) {
    if (threadIdx.x == 0) bcast[2] = xb_add(&p.BAR[0], 1u);
    __syncthreads();
    const int it = (int)bcast[2];
    __syncthreads();
    if (it >= 37 * 64) break;
    const int ct = it % 37, tt = it / 37;
    const bool isv = (ct == 14 || ct == 15 || ct == 18 || ct == 19);
    if (isv) gemm_tile_glds(p.XB, 2048, p.WINT, 2048, 2048, tt * 128, ct * 128, (unsigned char*)lds, EpiVT{p.VT});
    else     gemm_tile_glds(p.WINT, 2048, p.XB, 2048, 2048, ct * 128, tt * 128, (unsigned char*)lds, EpiH{p.H});
  }
}
DI void phase_gemm_mix(const Params& p, u16* lds) {
  for (int it = blockIdx.x; it < 16 * 64; it += gridDim.x) {
    int ct = it % 16, tt = it / 16;
    gemm_tile_glds(p.WOUTT, 2048, p.MIXB, 2048, 2048, ct * 128, tt * 128, (unsigned char*)lds, EpiMix{p.Y, p.x});
  }
}
DI void phase_gemm_pq(const Params& p, u16* lds) {
  for (int it = blockIdx.x; it < 16 * 64; it += gridDim.x) {
    int ct = it % 16, tt = it / 16;
    gemm_tile_glds(p.WQT, 2048, p.YB, 2048, 2048, ct * 128, tt * 128, (unsigned char*)lds, EpiPQ{p.PQ});
  }
}

DI bf16x8 add_pos(bf16x8 v, float4 a, float4 b) {
  uint4 u = __builtin_bit_cast(uint4, v);
  uint4 r = make_uint4(pack2(bflo(u.x) + a.x, bfhi(u.x) + a.y), pack2(bflo(u.y) + a.z, bfhi(u.y) + a.w),
                       pack2(bflo(u.z) + b.x, bfhi(u.z) + b.y), pack2(bflo(u.w) + b.z, bfhi(u.w) + b.w));
  return __builtin_bit_cast(bf16x8, r);
}
DI void compress_item(const Params& p, int item, u16* hid  ) {
  const int tid = threadIdx.x, lane = tid & 63, w = tid >> 6;
  const int l15 = lane & 15, quad = lane >> 4;
  const int kind = item >> 6;
  const int r0 = (item & 63) * 32;
  const u16* W1T = kind ? p.W1VT : p.W1KT;
  const u16* W2T = kind ? p.W2VT : p.W2KT;
  const float* posp = (kind ? p.pos_v : p.pos_k) + quad * 8;
  const u16* brow[2];
#pragma unroll
  for (int qi = 0; qi < 2; ++qi) {
    int r = r0 + qi * 16 + l15;
    if (r > 2039) r = 2039;
    int g = r & 3, bn = r >> 2;
    int b = bn / 255, n = bn % 255;
    brow[qi] = p.H + (size_t)(b * 4096 + 16 * n) * HS + COL_KV + kind * 256 + g * 64 + quad * 8;
  }
  const u16* arow = W1T + ((size_t)(w * 4) * 64 + lane) * 8;
  f32x4 acc[4][2];
#pragma unroll
  for (int i = 0; i < 4; ++i) { acc[i][0] = f32x4{0.f, 0.f, 0.f, 0.f}; acc[i][1] = f32x4{0.f, 0.f, 0.f, 0.f}; }
#pragma unroll 4
  for (int ks = 0; ks < 64; ++ks) {
    const int l = ks >> 1, d0 = (ks & 1) * 32;
    const float4 pa = *(const float4*)(posp + l * 64 + d0), pb4 = *(const float4*)(posp + l * 64 + d0 + 4);
    bf16x8 b0 = add_pos(ld8(brow[0] + (size_t)l * HS + d0), pa, pb4);
    bf16x8 b1 = add_pos(ld8(brow[1] + (size_t)l * HS + d0), pa, pb4);
#pragma unroll
    for (int i = 0; i < 4; ++i) {
      bf16x8 a = ld8(arow + (size_t)(ks * 16 + i) * 512);
      acc[i][0] = MFMA16(a, b0, acc[i][0]);
      acc[i][1] = MFMA16(a, b1, acc[i][1]);
    }
  }
#pragma unroll
  for (int i = 0; i < 4; ++i)
#pragma unroll
    for (int qi = 0; qi < 2; ++qi) {
      int j = w * 64 + i * 16 + quad * 4;
      float h0 = gelu_tanh(acc[i][qi][0]), h1 = gelu_tanh(acc[i][qi][1]);
      float h2 = gelu_tanh(acc[i][qi][2]), h3 = gelu_tanh(acc[i][qi][3]);
      *(uint2*)(hid + (qi * 16 + l15) * 264 + j) = make_uint2(pack2(h0, h1), pack2(h2, h3));
    }
  __syncthreads();
  f32x4 o2[2] = {f32x4{0.f, 0.f, 0.f, 0.f}, f32x4{0.f, 0.f, 0.f, 0.f}};
#pragma unroll
  for (int ks = 0; ks < 8; ++ks) {
    bf16x8 a = ld8(W2T + (size_t)(w * 16 + l15) * 256 + ks * 32 + quad * 8);
#pragma unroll
    for (int qi = 0; qi < 2; ++qi) {
      bf16x8 b = *(const bf16x8*)(hid + (qi * 16 + l15) * 264 + ks * 32 + quad * 8);
      o2[qi] = MFMA16(a, b, o2[qi]);
    }
  }
#pragma unroll
  for (int qi = 0; qi < 2; ++qi) {
    int r = r0 + qi * 16 + l15;
    if (r < 2040) {
      int g = r & 3, bn = r >> 2;
      int b = bn / 255, n = bn % 255;
      int d = w * 16 + quad * 4;
      if (kind == 0) {
        *(uint2*)(p.KC + ((((size_t)(b * 4 + g) * 16 + (n >> 4)) * 2 + (d >> 5)) * 64 + ((d >> 3) & 3) * 16 + (n & 15)) * 8 + (d & 7)) = make_uint2(pack2(o2[qi][0], o2[qi][1]), pack2(o2[qi][2], o2[qi][3]));
      } else {
        const int m = n & 31;
        u16* vp = p.VCT + (((((size_t)(b * 4 + g) * 4 + (n >> 6)) * 2 + ((n >> 5) & 1)) * 4 + (d >> 4)) * 64 + ((m & 15) >> 2) * 16 + (d & 15)) * 8 + (m & 3) + ((m >> 4) << 2);
        vp[0] = f2bf(o2[qi][0]); vp[8] = f2bf(o2[qi][1]); vp[16] = f2bf(o2[qi][2]); vp[24] = f2bf(o2[qi][3]);
      }
    }
  }
  if ((item & 63) == 0) {
    if (kind == 0) {
      if (tid < 8 * 64) { int bg = tid >> 5;   (void)bg; }
      for (int e = tid; e < 8 * 64; e += 256) { const int bg = e >> 6, dd = e & 63; p.KC[((((size_t)bg * 16 + 15) * 2 + (dd >> 5)) * 64 + ((dd >> 3) & 3) * 16 + 15) * 8 + (dd & 7)] = 0; }
    } else {
      for (int e = tid; e < 8 * 64; e += 256) { const int bg = e >> 6, dd = e & 63; p.VCT[(((((size_t)bg * 4 + 3) * 2 + 1) * 4 + (dd >> 4)) * 64 + 3 * 16 + (dd & 15)) * 8 + 7] = 0; }
    }
  }
  __syncthreads();
}

constexpr int CT = 16;
DI void conv_item(const Params& p, int item, float* red) {
  const int tid = threadIdx.x;
  const int tok0 = item * CT;
  const int t0 = tok0 & 4095;
  const int c = tid * 4;
  float res[CT][4];
  {
    float4 bv = *(const float4*)(p.dw_b + c);
#pragma unroll
    for (int o = 0; o < CT; ++o) { res[o][0] = bv.x; res[o][1] = bv.y; res[o][2] = bv.z; res[o][3] = bv.w; }
  }
  {
    const int tt0 = (t0 >= 30) ? 0 : (30 - t0);
    const u16* hp = p.H + (size_t)(tok0 - 30 + tt0) * HS + COL_CONV + c;
    const float* wp = p.dw_w + c;
    float4 wr[CT];
#pragma unroll
    for (int o = 0; o < CT; ++o) {
      const int tap = tt0 - o;
      wr[o] = (tap >= 0 && tap <= 30) ? *(const float4*)(wp + tap * 1024) : make_float4(0.f, 0.f, 0.f, 0.f);
    }
#pragma unroll 8
    for (int tt = tt0; tt < 30 + CT; ++tt, hp += HS) {
      const uint2 av = *(const uint2*)hp;
      const uint2 gv = *(const uint2*)(hp + 1024);
      const float4 wnext = (tt + 1 <= 30) ? *(const float4*)(wp + (tt + 1) * 1024) : make_float4(0.f, 0.f, 0.f, 0.f);
      const float u0 = bflo(av.x) * sigmoidf_(bflo(gv.x));
      const float u1 = bfhi(av.x) * sigmoidf_(bfhi(gv.x));
      const float u2 = bflo(av.y) * sigmoidf_(bflo(gv.y));
      const float u3 = bfhi(av.y) * sigmoidf_(bfhi(gv.y));
#pragma unroll
      for (int o = 0; o < CT; ++o) {
        res[o][0] += wr[o].x * u0;
        res[o][1] += wr[o].y * u1;
        res[o][2] += wr[o].z * u2;
        res[o][3] += wr[o].w * u3;
      }
#pragma unroll
      for (int o = CT - 1; o > 0; --o) wr[o] = wr[o - 1];
      wr[0] = wnext;
    }
  }
  float mu[CT], rs[CT];
  {
    const int lane = tid & 63, w = tid >> 6;
#pragma unroll
    for (int o = 0; o < CT; ++o) {
      const float s = wave_sum(res[o][0] + res[o][1] + res[o][2] + res[o][3]);
      if (lane == 0) red[w * CT + o] = s;
    }
    __syncthreads();
#pragma unroll
    for (int o = 0; o < CT; ++o) mu[o] = (red[o] + red[CT + o] + red[2 * CT + o] + red[3 * CT + o]) * (1.0f / 1024.0f);
    __syncthreads();
#pragma unroll
    for (int o = 0; o < CT; ++o) {
      const float a = res[o][0] - mu[o], b = res[o][1] - mu[o], c2 = res[o][2] - mu[o], d = res[o][3] - mu[o];
      const float s = wave_sum(a * a + b * b + c2 * c2 + d * d);
      if (lane == 0) red[w * CT + o] = s;
    }
    __syncthreads();
#pragma unroll
    for (int o = 0; o < CT; ++o) rs[o] = rsqrtf((red[o] + red[CT + o] + red[2 * CT + o] + red[3 * CT + o]) * (1.0f / 1024.0f) + LN_EPS);
    __syncthreads();
  }
  {
    const float4 gv = *(const float4*)(p.cln_g + c), bv = *(const float4*)(p.cln_b + c);
#pragma unroll
    for (int o = 0; o < CT; ++o) {
      float y0 = (res[o][0] - mu[o]) * rs[o] * gv.x + bv.x;
      float y1 = (res[o][1] - mu[o]) * rs[o] * gv.y + bv.y;
      float y2 = (res[o][2] - mu[o]) * rs[o] * gv.z + bv.z;
      float y3 = (res[o][3] - mu[o]) * rs[o] * gv.w + bv.w;
      y0 = y0 * sigmoidf_(y0); y1 = y1 * sigmoidf_(y1); y2 = y2 * sigmoidf_(y2); y3 = y3 * sigmoidf_(y3);
      *(uint2*)(p.MIXB + (size_t)(tok0 + o) * 2048 + 1024 + c) = make_uint2(pack2(y0, y1), pack2(y2, y3));
    }
  }
}

DI void qk4(const u16* __restrict__ Kb, int kstride, int key0, bf16x8 qf0, bf16x8 qf1, f32x4 (&s)[4], int l15, int quad) {
#pragma unroll
  for (int kt = 0; kt < 4; ++kt) {
    const u16* kr = Kb + (size_t)(key0 + kt * 16 + l15) * kstride + quad * 8;
    bf16x8 a0 = ld8(kr), a1 = ld8(kr + 32);
    f32x4 z = f32x4{0.f, 0.f, 0.f, 0.f};
    z = MFMA16(a0, qf0, z);
    z = MFMA16(a1, qf1, z);
    s[kt] = z;
  }
}
DI void qk4f(const u16* __restrict__ KCF, int c, bf16x8 qf0, bf16x8 qf1, f32x4 (&s)[4], int lane) {
#pragma unroll
  for (int kt = 0; kt < 4; ++kt) {
    const u16* kr = KCF + ((size_t)((c * 4 + kt) * 2) * 64 + lane) * 8;
    bf16x8 a0 = ld8(kr), a1 = ld8(kr + 512);
    f32x4 z = f32x4{0.f, 0.f, 0.f, 0.f};
    z = MFMA16(a0, qf0, z);
    z = MFMA16(a1, qf1, z);
    s[kt] = z;
  }
}
DI void pv4(const u16* __restrict__ Vt, int vstride, int key0, const f32x4 (&s)[4], f32x4 (&o)[4], int l15, int quad) {
#pragma unroll
  for (int ks2 = 0; ks2 < 2; ++ks2) {
    bf16x8 pb = packp(s[2 * ks2], s[2 * ks2 + 1]);
#pragma unroll
    for (int dt = 0; dt < 4; ++dt) {
      const u16* vr = Vt + (size_t)(dt * 16 + l15) * vstride + key0 + ks2 * 32 + quad * 4;
      uint2 lo = *(const uint2*)vr, hi = *(const uint2*)(vr + 16);
      o[dt] = MFMA16(comb(lo, hi), pb, o[dt]);
    }
  }
}
DI void pv4f(const u16* __restrict__ VCF, int c, const f32x4 (&s)[4], f32x4 (&o)[4], int lane) {
#pragma unroll
  for (int ks2 = 0; ks2 < 2; ++ks2) {
    bf16x8 pb = packp(s[2 * ks2], s[2 * ks2 + 1]);
#pragma unroll
    for (int dt = 0; dt < 4; ++dt)
      o[dt] = MFMA16(ld8(VCF + ((size_t)(((c * 2 + ks2) * 4 + dt) * 64) + lane) * 8), pb, o[dt]);
  }
}
DI void flash_block(const u16* __restrict__ Kb, const u16* __restrict__ Vt, int key0, int tq, float slope, bool rowok, int win,
                    bf16x8 qf0, bf16x8 qf1, float& m, float& l, f32x4 (&o)[4], int l15, int quad) {
  f32x4 s[4];
  qk4(Kb, HS, key0, qf0, qf1, s, l15, quad);
  float bm = -1e30f;
#pragma unroll
  for (int kt = 0; kt < 4; ++kt)
#pragma unroll
    for (int i = 0; i < 4; ++i) {
      int dist = tq - (key0 + kt * 16 + quad * 4 + i);
      bool valid = rowok && dist >= 0 && dist < win;
      float sv = valid ? (s[kt][i] * 0.125f - slope * (float)dist) : -1e30f;
      s[kt][i] = sv;
      bm = fmaxf(bm, sv);
    }
  bm = quad_maxf(bm);
  const float mn = fmaxf(m, bm);
  const float alpha = __expf(m - mn);
  float ps = 0.f;
#pragma unroll
  for (int kt = 0; kt < 4; ++kt)
#pragma unroll
    for (int i = 0; i < 4; ++i) {
      float sv = s[kt][i];
      float pv = (sv > -1e29f) ? __expf(sv - mn) : 0.f;
      s[kt][i] = pv;
      ps += pv;
    }
  ps = quad_sumf(ps);
  l = l * alpha + ps;
  m = mn;
#pragma unroll
  for (int dt = 0; dt < 4; ++dt) { o[dt][0] *= alpha; o[dt][1] *= alpha; o[dt][2] *= alpha; o[dt][3] *= alpha; }
  pv4(Vt, 4096, key0, s, o, l15, quad);
}

DI void nsa_item(const Params& p, int item, float* implds  , unsigned char* kvlds  ) {
  const int tid = threadIdx.x, lane = tid & 63, w = tid >> 6;
  const int l15 = lane & 15, quad = lane >> 4;
  int qt = item & 255; const int g = (item >> 8) & 3, b = item >> 10;
  const int t0 = qt * 16, tq = t0 + w * 4 + (l15 >> 2);
  const int hh = g * 4 + (l15 & 3);
  const float slope = exp2f(-0.5f * (float)(hh + 1));
  const size_t tokbase = (size_t)b * 4096;
  const u16* Hq = p.H + (tokbase + tq) * HS + hh * 64;
  const bf16x8 qf0 = ld8(Hq + quad * 8), qf1 = ld8(Hq + 32 + quad * 8);
  const u16* gp = p.H + (tokbase + tq) * HS + COL_GATE + hh * 3;
  const float g0 = sigmoidf_(bf2f(gp[0])), g1 = sigmoidf_(bf2f(gp[1])), g2 = sigmoidf_(bf2f(gp[2]));

  const u16* KCb = p.KC + ((size_t)(b * 4 + g) * 256) * 64;
  const u16* VCTb = p.VCT + ((size_t)(b * 4 + g) * 64) * 256;
  const int nmax = (t0 - 16) >> 4;
  const int nch = (nmax < 0) ? 0 : ((nmax >> 6) + 1);
  float mc = -1e30f, lc = 0.f;
#pragma unroll 1
  for (int c = 0; c < nch; ++c) {
    f32x4 s[4];
    qk4f(KCb, c, qf0, qf1, s, lane);
    float bm = -1e30f;
#pragma unroll
    for (int kt = 0; kt < 4; ++kt)
#pragma unroll
      for (int i = 0; i < 4; ++i) {
        int ce = 16 * (c * 64 + kt * 16 + quad * 4 + i) + 31;
        float sv = (ce <= tq) ? (s[kt][i] * 0.125f - slope * (float)(tq - ce)) : -1e30f;
        s[kt][i] = sv;
        bm = fmaxf(bm, sv);
      }
    bm = quad_maxf(bm);
    const float mn = fmaxf(mc, bm);
    float ps = 0.f;
#pragma unroll
    for (int kt = 0; kt < 4; ++kt)
#pragma unroll
      for (int i = 0; i < 4; ++i) ps += (s[kt][i] > -1e29f) ? __expf(s[kt][i] - mn) : 0.f;
    ps = quad_sumf(ps);
    lc = lc * __expf(mc - mn) + ps;
    mc = mn;
  }
  const float inv = lc > 0.f ? 1.0f / lc : 0.f;
  f32x4 oacc[4];
#pragma unroll
  for (int dt = 0; dt < 4; ++dt) oacc[dt] = f32x4{0.f, 0.f, 0.f, 0.f};
  {
    float* lastlds = (float*)kvlds;
#pragma unroll 1
    for (int c = 0; c < 4; ++c) {
      f32x4 s[4];
      if (c < nch) {
        qk4f(KCb, c, qf0, qf1, s, lane);
#pragma unroll
        for (int kt = 0; kt < 4; ++kt)
#pragma unroll
          for (int i = 0; i < 4; ++i) {
            int ce = 16 * (c * 64 + kt * 16 + quad * 4 + i) + 31;
            float sv = s[kt][i] * 0.125f - slope * (float)(tq - ce);
            s[kt][i] = (ce <= tq) ? __expf(sv - mc) * inv : 0.f;
          }
        pv4f(VCTb, c, s, oacc, lane);
      } else {
#pragma unroll
        for (int kt = 0; kt < 4; ++kt) s[kt] = f32x4{0.f, 0.f, 0.f, 0.f};
      }
#pragma unroll
      for (int kt = 0; kt < 4; ++kt) {
        implds[(w * 16 + c * 4 + kt) * 64 + lane] = s[kt][0] + s[kt][1] + s[kt][2] + s[kt][3];
        lastlds[(w * 16 + c * 4 + kt) * 64 + lane] = s[kt][3];
      }
    }
  }
#pragma unroll
  for (int dt = 0; dt < 4; ++dt) { oacc[dt][0] *= g0; oacc[dt][1] *= g0; oacc[dt][2] *= g0; oacc[dt][3] *= g0; }
  const int cur = tq >> 6;
  u64 sel = 0;
  {
    int v[16];
#pragma unroll
    for (int jj = 0; jj < 16; ++jj) {
      const int j = jj * 4 + quad;
      float a = implds[(w * 16 + jj) * 64 + lane];
      {
        const float* lastlds = (const float*)kvlds;
        const int pj = (quad > 0) ? jj : jj - 1;
        const int pl = (quad > 0) ? lane - 16 : lane + 48;
        const float nbv = lastlds[(w * 16 + (pj < 0 ? 0 : pj)) * 64 + pl];
        a += (pj < 0) ? 0.f : nbv;
      }
      a += dppf<0xB1>(a);
      a += dppf<0x4E>(a);
      const bool forced = (j == 0) || (j == cur) || (j == cur - 1);
      if (forced) a += 1.0e4f;
      if (j * 64 > tq) a = -1.0f;
      v[jj] = (__float_as_int(a) & ~63) | (63 - j);
    }
#pragma unroll 1
    for (int r = 0; r < 16; ++r) {
      int bv = v[0];
#pragma unroll
      for (int jj = 1; jj < 16; ++jj) bv = max(bv, v[jj]);
      bv = quad_maxi(bv);
      sel |= 1ull << (63 - (bv & 63));
#pragma unroll
      for (int jj = 0; jj < 16; ++jj) v[jj] = (v[jj] == bv) ? (int)0x80000000 : v[jj];
    }
    if (cur < 63) sel &= ((1ull << (cur + 1)) - 1ull);
  }
  u64 U, Uw;
  {
    unsigned lo = (unsigned)sel, hi = (unsigned)(sel >> 32);
    lo = row_or(lo); hi = row_or(hi);
    lo = __builtin_amdgcn_readfirstlane(lo); hi = __builtin_amdgcn_readfirstlane(hi);
    Uw = ((u64)hi << 32) | lo;
    unsigned* ux = (unsigned*)(kvlds + 2 * 64 * 72 * 2);
    if (lane == 0) { ux[w * 2] = lo; ux[w * 2 + 1] = hi; }
    __syncthreads();
    lo = ux[0] | ux[2] | ux[4] | ux[6]; hi = ux[1] | ux[3] | ux[5] | ux[7];
    lo = __builtin_amdgcn_readfirstlane(lo); hi = __builtin_amdgcn_readfirstlane(hi);
    U = ((u64)hi << 32) | lo;
  }
  {
    float ms = -1e30f, ls = 0.f, mw = -1e30f, lw = 0.f;
    f32x4 os[4], ow[4];
#pragma unroll
    for (int dt = 0; dt < 4; ++dt) { os[dt] = f32x4{0.f, 0.f, 0.f, 0.f}; ow[dt] = f32x4{0.f, 0.f, 0.f, 0.f}; }
    int jw = t0 - 511; if (jw < 0) jw = 0; jw >>= 6;
    const int jhi = (t0 + 15) >> 6;
    const int nsteps = __builtin_popcountll(U) + (jhi - jw + 1);
    const float SL2 = slope * 1.4426950408889634f, QS = 0.125f * 1.4426950408889634f;
    const float aq = -SL2 * (float)tq;
    float cE[4][4];
#pragma unroll
    for (int kt = 0; kt < 4; ++kt)
#pragma unroll
      for (int i = 0; i < 4; ++i) cE[kt][i] = SL2 * (float)(kt * 16 + quad * 4 + i);
    u16* tiles = (u16*)kvlds;
    const int srow = tid >> 3, scc = tid & 7;
    const u16* kbl = p.H + (tokbase + srow) * HS + COL_KV + 2 * 256 + g * 64 + scc * 8;
    const u16* vbl = p.VT + ((size_t)((0 * 2 + b) * 4 + g) * 64 + srow) * 4096 + scc * 8;
    uint4 rk0, rk1, rv0, rv1;
    int nkind, nj;
#define NSA_NEXT() do { if (U) { nkind = 0; nj = __builtin_ctzll(U); U &= U - 1; } else { nkind = 1; nj = jw++; } } while (0)
#define NSA_FETCH() do { const u16* kb_ = kbl + (size_t)(nj * 64) * HS + nkind * 512; \
      const u16* vb_ = vbl + (size_t)nkind * (2 * 4 * 64 * 4096) + nj * 64; \
      rk0 = *(const uint4*)kb_; rk1 = *(const uint4*)(kb_ + (size_t)32 * HS); \
      rv0 = *(const uint4*)vb_; rv1 = *(const uint4*)(vb_ + (size_t)32 * 4096); } while (0)
    NSA_NEXT();
    NSA_FETCH();
#pragma unroll 1
    for (int st = 0; st < nsteps; ++st) {
      u16* sK = tiles + (st & 1) * (2 * 64 * 72);
      u16* sV = sK + 64 * 72;
      *(uint4*)(sK + srow * 72 + scc * 8) = rk0; *(uint4*)(sK + (srow + 32) * 72 + scc * 8) = rk1;
      *(uint4*)(sV + srow * 72 + scc * 8) = rv0; *(uint4*)(sV + (srow + 32) * 72 + scc * 8) = rv1;
      const int ckind = nkind, cj = nj;
      __syncthreads();
      if (st + 1 < nsteps) { NSA_NEXT(); NSA_FETCH(); }
      if (ckind || ((Uw >> cj) & 1ull)) {
      const int key0 = cj * 64;
      f32x4 s[4];
#pragma unroll
      for (int kt = 0; kt < 4; ++kt) {
        const u16* kr = sK + (kt * 16 + l15) * 72 + quad * 8;
        bf16x8 a0 = *(const bf16x8*)kr, a1 = *(const bf16x8*)(kr + 32);
        f32x4 z = f32x4{0.f, 0.f, 0.f, 0.f};
        z = MFMA16(a0, qf0, z);
        z = MFMA16(a1, qf1, z);
        s[kt] = z;
      }
      const float mold = ckind ? mw : ms;
      const float base = aq + SL2 * (float)key0;
      const int thr2 = tq - key0 - quad * 4;
      float bm = -1e30f;
      if (ckind) {
        const int thr3 = thr2 - 512;
#pragma unroll
        for (int kt = 0; kt < 4; ++kt)
#pragma unroll
          for (int i = 0; i < 4; ++i) {
            const float x = fmaf(s[kt][i], QS, base + cE[kt][i]);
            const bool valid = (kt * 16 + i <= thr2) && (kt * 16 + i > thr3);
            const float sv = valid ? x : -1e30f;
            s[kt][i] = sv;
            bm = fmaxf(bm, sv);
          }
      } else {
        const bool rowok = (bool)((sel >> cj) & 1ull);
#pragma unroll
        for (int kt = 0; kt < 4; ++kt)
#pragma unroll
          for (int i = 0; i < 4; ++i) {
            const float x = fmaf(s[kt][i], QS, base + cE[kt][i]);
            const bool valid = rowok && (kt * 16 + i <= thr2);
            const float sv = valid ? x : -1e30f;
            s[kt][i] = sv;
            bm = fmaxf(bm, sv);
          }
      }
      bm = quad_maxf(bm);
      const float mn = fmaxf(mold, bm);
      const float alpha = __builtin_amdgcn_exp2f(mold - mn);
      const float mne = fmaxf(mn, -1e20f);
      float ps = 0.f;
#pragma unroll
      for (int kt = 0; kt < 4; ++kt)
#pragma unroll
        for (int i = 0; i < 4; ++i) {
          const float pv = __builtin_amdgcn_exp2f(s[kt][i] - mne);
          s[kt][i] = pv;
          ps += pv;
        }
      ps = quad_sumf(ps);
      bf16x8 pb0 = packp(s[0], s[1]), pb1 = packp(s[2], s[3]);
      if (ckind) {
        lw = lw * alpha + ps; mw = mn;
#pragma unroll
        for (int dt = 0; dt < 4; ++dt) {
          ow[dt][0] *= alpha; ow[dt][1] *= alpha; ow[dt][2] *= alpha; ow[dt][3] *= alpha;
          const u16* vr = sV + (dt * 16 + l15) * 72 + quad * 4;
          ow[dt] = MFMA16(comb(*(const uint2*)vr, *(const uint2*)(vr + 16)), pb0, ow[dt]);
          ow[dt] = MFMA16(comb(*(const uint2*)(vr + 32), *(const uint2*)(vr + 48)), pb1, ow[dt]);
        }
      } else {
        ls = ls * alpha + ps; ms = mn;
#pragma unroll
        for (int dt = 0; dt < 4; ++dt) {
          os[dt][0] *= alpha; os[dt][1] *= alpha; os[dt][2] *= alpha; os[dt][3] *= alpha;
          const u16* vr = sV + (dt * 16 + l15) * 72 + quad * 4;
          os[dt] = MFMA16(comb(*(const uint2*)vr, *(const uint2*)(vr + 16)), pb0, os[dt]);
          os[dt] = MFMA16(comb(*(const uint2*)(vr + 32), *(const uint2*)(vr + 48)), pb1, os[dt]);
        }
      }
      }
    }
#undef NSA_NEXT
#undef NSA_FETCH
    __syncthreads();
    const float scs = g1 / ls, scw = g2 / lw;
#pragma unroll
    for (int dt = 0; dt < 4; ++dt) {
      oacc[dt][0] += scs * os[dt][0] + scw * ow[dt][0]; oacc[dt][1] += scs * os[dt][1] + scw * ow[dt][1];
      oacc[dt][2] += scs * os[dt][2] + scw * ow[dt][2]; oacc[dt][3] += scs * os[dt][3] + scw * ow[dt][3];
    }
  }
  u16* op = p.MIXB + (tokbase + tq) * 2048 + hh * 64 + quad * 4;
#pragma unroll
  for (int dt = 0; dt < 4; ++dt)
    *(uint2*)(op + dt * 16) = make_uint2(pack2(oacc[dt][0], oacc[dt][1]), pack2(oacc[dt][2], oacc[dt][3]));
}

DI void ln1_item(const Params& p, int item) {
  const int lane = threadIdx.x & 63, w = threadIdx.x >> 6;
  const int row = item * 4 + w;
  float* yr = p.Y + (size_t)row * 2048;
  float4 v[8];
  float s = 0.f;
#pragma unroll
  for (int i = 0; i < 8; ++i) { v[i] = *(const float4*)(yr + (lane + 64 * i) * 4); s += v[i].x + v[i].y + v[i].z + v[i].w; }
  const float mu = wave_sum(s) * (1.0f / 2048.0f);
  float q = 0.f;
#pragma unroll
  for (int i = 0; i < 8; ++i) { float a = v[i].x - mu, b = v[i].y - mu, c = v[i].z - mu, d = v[i].w - mu; q += a * a + b * b + c * c + d * d; }
  const float rs = rsqrtf(wave_sum(q) * (1.0f / 2048.0f) + LN_EPS);
#pragma unroll
  for (int i = 0; i < 8; ++i) {
    int c = (lane + 64 * i) * 4;
    float4 gv = *(const float4*)(p.ln1_g + c), bv = *(const float4*)(p.ln1_b + c);
    float4 o = make_float4((v[i].x - mu) * rs * gv.x + bv.x, (v[i].y - mu) * rs * gv.y + bv.y, (v[i].z - mu) * rs * gv.z + bv.z, (v[i].w - mu) * rs * gv.w + bv.w);
    *(float4*)(yr + c) = o;
    *(uint2*)(p.YB + (size_t)row * 2048 + c) = make_uint2(pack2(o.x, o.y), pack2(o.z, o.w));
  }
}

DI void peer_select_item(const Params& p, int item, float* lds) {
  const int lane = threadIdx.x & 63, w = threadIdx.x >> 6;
  const int l15 = lane & 15, quad = lane >> 4;
  const int tile = item >> 1, h = (item & 1) * 4 + w;
  const int tok = tile * 16 + l15;
  const u16* qfr = p.PQ + (((size_t)tile * 16 + h * 2) * 4 * 64 + lane) * 8;
  float* lv = lds + w * 1536;
  int* li = (int*)(lv + 512);
  float* tvl = lv + 1024;
  int* el = (int*)(lv + 1280);
#pragma unroll 1
  for (int c = 0; c < 2; ++c) {
    bf16x8 bq[4];
#pragma unroll
    for (int ks = 0; ks < 4; ++ks) bq[ks] = ld8(qfr + (size_t)((c * 4 + ks) * 64) * 8);
    const u16* kb = p.PKEYS + ((size_t)(h * 2 + c) * 2048 + lane) * 8;
    int a[32];
#pragma unroll
    for (int kt = 0; kt < 8; ++kt) {
      f32x4 z = f32x4{0.f, 0.f, 0.f, 0.f};
#pragma unroll
      for (int ks = 0; ks < 4; ++ks) z = MFMA16(ld8(kb + (size_t)(kt * 4 + ks) * 512), bq[ks], z);
#pragma unroll
      for (int i = 0; i < 4; ++i) {
        const int b = __float_as_int(z[i]);
        const int k = b ^ ((b >> 31) & 0x7fffffff);
        a[kt * 4 + i] = (k & ~127) | (127 - (kt * 16 + quad * 4 + i));
      }
    }
#pragma unroll
    for (int k = 2; k <= 32; k <<= 1) {
#pragma unroll
      for (int j = k >> 1; j > 0; j >>= 1) {
#pragma unroll
        for (int i = 0; i < 32; ++i) {
          const int l = i ^ j;
          if (l > i) {
            const bool desc = ((i & k) == 0);
            const int hi = max(a[i], a[l]), lo = min(a[i], a[l]);
            a[i] = desc ? hi : lo; a[l] = desc ? lo : hi;
          }
        }
      }
    }
#pragma unroll 1
    for (int r = 0; r < 16; ++r) {
      const int bk = quad_maxi(a[0]);
      if (quad == 0) {
        const int kv = bk & ~127;
        lv[(c * 16 + r) * 16 + l15] = __int_as_float(kv ^ ((kv >> 31) & 0x7fffffff));
        li[(c * 16 + r) * 16 + l15] = 127 - (bk & 127);
      }
      const bool win = (a[0] == bk);
#pragma unroll
      for (int i = 0; i < 15; ++i) a[i] = win ? a[i + 1] : a[i];
      a[15] = win ? (int)0x80000000 : a[15];
    }
  }
  __builtin_amdgcn_wave_barrier();
  float cv[13]; int cf[13];
#pragma unroll
  for (int k = 0; k < 13; ++k) {
    int a, bb; bool ok = true;
    if (k < 4) { a = 0; bb = k * 4 + quad; }
    else if (k < 6) { a = 1; bb = (k - 4) * 4 + quad; }
    else if (k == 6) { a = 2; bb = quad; }
    else if (k == 7) { a = 3; bb = quad; }
    else if (k == 8) { a = 8 + quad; bb = 0; }
    else if (k == 9) { a = 12 + quad; bb = 0; }
    else if (k == 10) { a = 4 + quad; bb = 0; }
    else if (k == 11) { a = 4 + quad; bb = 1; }
    else { a = (quad == 0) ? 2 : 4; bb = (quad == 0) ? 4 : 2; ok = quad < 2; }
    float v = lv[(0 * 16 + a) * 16 + l15] + lv[(1 * 16 + bb) * 16 + l15];
    cv[k] = ok ? v : -3.0e38f;
    cf[k] = ok ? (a * 16 + bb) : 999;
  }
  float tmax = 0.f, sum = 0.f;
#pragma unroll 1
  for (int r = 0; r < 16; ++r) {
    float bv = cv[0];
#pragma unroll
    for (int k = 1; k < 13; ++k) bv = fmaxf(bv, cv[k]);
    bv = quad_maxf(bv);
    int bi = 1000;
#pragma unroll
    for (int k = 0; k < 13; ++k) bi = (cv[k] == bv) ? min(bi, cf[k]) : bi;
    bi = quad_mini(bi);
    if (r == 0) tmax = bv;
    const float e = __expf(bv - tmax);
    sum += e;
    if (quad == 0) {
      const int a = bi >> 4, bb = bi & 15;
      el[r * 16 + l15] = li[(0 * 16 + a) * 16 + l15] * 128 + li[(1 * 16 + bb) * 16 + l15];
      tvl[r * 16 + l15] = e;
    }
#pragma unroll
    for (int k = 0; k < 13; ++k) cv[k] = (cf[k] == bi) ? -3.0e38f : cv[k];
  }
  __builtin_amdgcn_wave_barrier();
  {
    const float isum = 1.0f / sum;
    int* ep = p.EIDX + (size_t)tok * 128 + h * 16 + quad * 4;
    float* gw = p.GW + (size_t)tok * 128 + h * 16 + quad * 4;
    const int r0 = quad * 4;
    *(int4*)ep = make_int4(el[(r0 + 0) * 16 + l15], el[(r0 + 1) * 16 + l15], el[(r0 + 2) * 16 + l15], el[(r0 + 3) * 16 + l15]);
    *(float4*)gw = make_float4(tvl[(r0 + 0) * 16 + l15] * isum, tvl[(r0 + 1) * 16 + l15] * isum, tvl[(r0 + 2) * 16 + l15] * isum, tvl[(r0 + 3) * 16 + l15] * isum);
  }
  __builtin_amdgcn_wave_barrier();
}

#ifndef GB
#define GB 16
#endif
DI void peer_gather_item(const Params& p, int item, float* lds  ) {
  const int tid = threadIdx.x, lane = tid & 63, w = tid >> 6;
  const int tok = item * 4 + w;
  float* coef = lds + w * 128;
  int* idl = (int*)(lds + 512) + w * 128;
  const float* yrow = p.Y + (size_t)tok * 2048 + lane * 4;
  const int* eix = p.EIDX + (size_t)tok * 128;
  const float* gwp = p.GW + (size_t)tok * 128;
  const unsigned char* UBq = (const unsigned char*)p.UB;
  const unsigned char* VBq = (const unsigned char*)p.VB;
  idl[lane] = p.EIDX[(size_t)tok * 128 + lane]; idl[64 + lane] = p.EIDX[(size_t)tok * 128 + 64 + lane];
  float y[32];
#pragma unroll
  for (int j = 0; j < 8; ++j) {
    float4 a = *(const float4*)(yrow + j * 256);
    y[j * 4 + 0] = a.x; y[j * 4 + 1] = a.y; y[j * 4 + 2] = a.z; y[j * 4 + 3] = a.w;
  }
#pragma unroll 1
  for (int e8 = 0; e8 < 128; e8 += GB) {
    uint4 ra[GB]; uint2 rb[GB];
    int idx[GB];
#pragma unroll
    for (int u = 0; u < GB; ++u) {
      idx[u] = __builtin_amdgcn_readfirstlane(idl[e8 + u]);
      const unsigned char* up = UBq + (size_t)idx[u] * ROWB;
      ra[u] = *(const uint4*)(up + lane * 16);
      rb[u] = *(const uint2*)(up + 1024 + lane * 8);
    }
#pragma unroll
    for (int u = 0; u < GB; ++u) {
      const v6u q = {ra[u].x, ra[u].y, ra[u].z, ra[u].w, rb[u].x, rb[u].y};
      const v32f dv = __builtin_amdgcn_cvt_scalef32_pk32_f32_fp6(q, 1.0f);
      float d0 = 0.f, d1 = 0.f, d2 = 0.f, d3 = 0.f;
#pragma unroll
      for (int k = 0; k < 32; k += 4) { d0 += y[k] * dv[k]; d1 += y[k + 1] * dv[k + 1]; d2 += y[k + 2] * dv[k + 2]; d3 += y[k + 3] * dv[k + 3]; }
      float d = wave_sum((d0 + d1) + (d2 + d3)) * p.USC[idx[u]];
      if (lane == 0) coef[e8 + u] = gelu_tanh(d) * gwp[e8 + u] * p.VSC[idx[u]];
    }
  }
  float acc[32];
#pragma unroll
  for (int i = 0; i < 32; ++i) acc[i] = DN_ALPHA * y[i];
#pragma unroll 1
  for (int e8 = 0; e8 < 128; e8 += GB) {
    uint4 ra[GB]; uint2 rb[GB];
    float cf[GB];
#pragma unroll
    for (int u = 0; u < GB; ++u) {
      const int idx = __builtin_amdgcn_readfirstlane(idl[e8 + u]);
      cf[u] = coef[e8 + u];
      const unsigned char* vp = VBq + (size_t)idx * ROWB;
      ra[u] = *(const uint4*)(vp + lane * 16);
      rb[u] = *(const uint2*)(vp + 1024 + lane * 8);
    }
#pragma unroll
    for (int u = 0; u < GB; ++u) {
      const v6u q = {ra[u].x, ra[u].y, ra[u].z, ra[u].w, rb[u].x, rb[u].y};
      const v32f dv = __builtin_amdgcn_cvt_scalef32_pk32_f32_fp6(q, 1.0f);
#pragma unroll
      for (int k = 0; k < 32; ++k) acc[k] += cf[u] * dv[k];
    }
  }
  float s = 0.f;
#pragma unroll
  for (int i = 0; i < 32; ++i) s += acc[i];
  const float mu = wave_sum(s) * (1.0f / 2048.0f);
  float qv = 0.f;
#pragma unroll
  for (int i = 0; i < 32; ++i) { float d = acc[i] - mu; qv += d * d; }
  const float rs = rsqrtf(wave_sum(qv) * (1.0f / 2048.0f) + LN_EPS);
  float* op = p.out + (size_t)tok * 2048 + lane * 4;
#pragma unroll
  for (int j = 0; j < 8; ++j) {
    const float4 gv = *(const float4*)(p.ln2_g + j * 256 + lane * 4), bv = *(const float4*)(p.ln2_b + j * 256 + lane * 4);
    *(float4*)(op + j * 256) = make_float4((acc[j * 4 + 0] - mu) * rs * gv.x + bv.x, (acc[j * 4 + 1] - mu) * rs * gv.y + bv.y,
                                         (acc[j * 4 + 2] - mu) * rs * gv.z + bv.z, (acc[j * 4 + 3] - mu) * rs * gv.w + bv.w);
  }
}

constexpr int LDS_BYTES = 65536;
__global__ void __launch_bounds__(256, 2) mega(Params p) {
  __shared__ __attribute__((aligned(16))) unsigned char smem[LDS_BYTES];
  __shared__ uint4 xb_words;
  const int lo = (int)p.phase_lo, hi = (int)p.phase_hi;
  if (threadIdx.x == 0) xb_words = make_uint4(0u, 0u, 0u, 0u);
  __syncthreads();
  volatile LAS unsigned* const xst = (volatile LAS unsigned*)&xb_words;
  if (threadIdx.x == 0) (void)xb_add(&p.BAR[XB_XCNT(xb_xcc_id())], 1u);
  if (lo > 1000) cg::this_grid().sync();
#ifdef ONLY_PHASE
#define PH_ON(n) ((n) == ONLY_PHASE)
#else
#define PH_ON(n) true
#endif
#ifndef REP_MASK
#define REP_MASK 0
#endif
#define PH_BEGIN(n) if (PH_ON(n) && lo <= (n) && (n) < hi) { if ((n) > lo) xcd_barrier(p.BAR, xst); for (int rep_ = 0; rep_ < 1 + ((REP_MASK >> (n)) & 1); ++rep_) {
#define PH_END } }
  PH_BEGIN(0) phase_prep(p, (float*)smem); PH_END
  PH_BEGIN(1) phase_gemm1(p, (u16*)smem, xst); PH_END
  PH_BEGIN(2)
    for (int it = blockIdx.x; it < 128; it += gridDim.x) compress_item(p, it, (u16*)smem);
    for (;;) {
      if (threadIdx.x == 0) xst[2] = xb_add(&p.BAR[2], 1u);
      __syncthreads();
      const int k = (int)xst[2];
      __syncthreads();
      if (k >= NTOK / CT) break;
      conv_item(p, k, (float*)smem);
    }
  PH_END
  PH_BEGIN(3)
    if (blockIdx.x % 5 == 0) {
      const int nq = (gridDim.x + 4) / 5;
      for (int c = blockIdx.x / 5; c < 512; c += nq) {
        if (c < 256) quant_rows_fp6(p.pu, (unsigned char*)p.UB, p.USC, c * 64, 64);
        else         quant_rows_fp6(p.pv, (unsigned char*)p.VB, p.VSC, (c - 256) * 64, 64);
      }
      transpose_cvt(p.w_out, 2048, 2048, p.WOUTT, 2048, (float*)smem, blockIdx.x / 5, nq);
      transpose_cvt(p.wq, 2048, 2048, p.WQT, 2048, (float*)smem, blockIdx.x / 5, nq);
    }
    for (;;) {
      if (threadIdx.x == 0) xst[2] = xb_add(&p.BAR[1], 1u);
      __syncthreads();
      const int k = (int)xst[2];
      __syncthreads();
      if (k >= 2048) break;
      nsa_item(p, ((k & 7) << 8) | (255 - (k >> 3)), (float*)smem, smem + 16384);
    }
  PH_END
  PH_BEGIN(4) phase_gemm_mix(p, (u16*)smem); PH_END
  PH_BEGIN(5)
    for (int it = blockIdx.x; it < 2048; it += gridDim.x) ln1_item(p, it);
  PH_END
  PH_BEGIN(6) phase_gemm_pq(p, (u16*)smem); PH_END
  PH_BEGIN(7)
    for (int it = blockIdx.x; it < 1024; it += gridDim.x) peer_select_item(p, it, (float*)smem);
  PH_END
  PH_BEGIN(8)
    for (int it = blockIdx.x; it < NTOK / 4; it += gridDim.x) peer_gather_item(p, it, (float*)smem);
  PH_END
}

extern "C" void kernel_launch(void* const* d_in, const int* in_sizes, int n_in, void* d_out, int out_size,
                              void* d_ws, size_t ws_size, hipStream_t stream) {
  Params p{};
  const float** f = (const float**)&p;
  for (int i = 0; i < 21; ++i) f[i] = (const float*)d_in[i];
  p.out = (float*)d_out;
  unsigned char* ws = (unsigned char*)d_ws;
  size_t off = 0;
  auto take = [&](size_t bytes) { unsigned char* r = ws + off; off += (bytes + 255) & ~(size_t)255; return r; };
  p.XB = (u16*)take((size_t)NTOK * 2048 * 2);
  p.WINT = (u16*)take((size_t)HS * 2048 * 2);
  p.WOUTT = (u16*)take((size_t)2048 * 2048 * 2);
  p.WQT = (u16*)take((size_t)2048 * 2048 * 2);
  p.W1KT = (u16*)take((size_t)256 * 2048 * 2);
  p.W1VT = (u16*)take((size_t)256 * 2048 * 2);
  p.W2KT = (u16*)take((size_t)64 * 256 * 2);
  p.W2VT = (u16*)take((size_t)64 * 256 * 2);
  p.PKEYS = (u16*)take((size_t)8 * 2 * 128 * 128 * 2);
  p.UB = (u16*)take((size_t)16384 * ROWB);
  p.VB = (u16*)take((size_t)16384 * ROWB);
  p.USC = (float*)take(16384 * 4);
  p.VSC = (float*)take(16384 * 4);
  p.H = (u16*)take((size_t)NTOK * HS * 2);
  p.VT = (u16*)take((size_t)2 * 2 * 4 * 64 * 4096 * 2);
  p.KC = (u16*)take((size_t)8 * 256 * 64 * 2);
  p.VCT = (u16*)take((size_t)8 * 64 * 256 * 2);
  p.MIXB = (u16*)take((size_t)NTOK * 2048 * 2);
  p.BIAS = (float*)take(512 * 4);
  p.Y = (float*)take((size_t)NTOK * 2048 * 4);
  p.GW = (float*)take((size_t)NTOK * 128 * 4);
  p.EIDX = (int*)take((size_t)NTOK * 128 * 4);
  p.BAR = (unsigned*)take(XCD_BAR_WORDS * 4);
  p.YB = p.XB;
  p.PQ = p.MIXB;
  if (off > ws_size) { fprintf(stderr, "kernel_launch: workspace too small (%zu > %zu)\n", off, ws_size); return; }

  static int grid_blocks = 0;
  if (!grid_blocks) {
    int dev = 0, cus = 0, per_cu = 0;
    hipGetDevice(&dev);
    hipDeviceGetAttribute(&cus, hipDeviceAttributeMultiprocessorCount, dev);
    hipOccupancyMaxActiveBlocksPerMultiprocessor(&per_cu, mega, 256, 0);
    if (per_cu < 1) per_cu = 1;
    grid_blocks = cus * per_cu;
  }
  (void)hipMemsetAsync(p.BAR, 0, XCD_BAR_WORDS * 4, stream);
#if N_LAUNCH_MODE == 1
  p.phase_lo = 0; p.phase_hi = NPHASE;
  void* args[] = {&p};
  hipError_t e = hipLaunchCooperativeKernel((void*)mega, dim3(grid_blocks), dim3(256), args, 0, stream);
  if (e != hipSuccess) fprintf(stderr, "cooperative launch failed: %s (grid %d)\n", hipGetErrorString(e), grid_blocks);
#else
  for (int ph = 0; ph < NPHASE; ++ph) {
    p.phase_lo = ph; p.phase_hi = ph + 1;
    hipLaunchKernelGGL(mega, dim3(grid_blocks), dim3(256), 0, stream, p);
  }
#endif
}
```

```cpp
#include <hip/hip_runtime.h>
#include <hip/hip_cooperative_groups.h>
#include <cstdio>
namespace cg = cooperative_groups;

typedef unsigned short u16;
typedef unsigned long long u64;
using bf16x8 = __attribute__((ext_vector_type(8))) short;
using f32x4  = __attribute__((ext_vector_type(4))) float;
#define DI __device__ __forceinline__
#define MFMA16(a, b, c) __builtin_amdgcn_mfma_f32_16x16x32_bf16((a), (b), (c), 0, 0, 0)

#ifndef N_LAUNCH_MODE
#define N_LAUNCH_MODE 1
#endif

constexpr int D_MODEL = 2048, SEQ = 4096, NTOK = 8192;
constexpr int D_IN = 4656, HS = 4736;
constexpr int COL_KV = 1024, COL_GATE = 2560, COL_CONV = 2608;
constexpr float DN_ALPHA = 1.189207115002721f;
constexpr float LN_EPS = 1e-5f;
constexpr int NPHASE = 9;

struct Params {
  const float *x, *w_in, *pos_k, *w1_k, *w2_k, *pos_v, *w1_v, *w2_v, *dw_w, *dw_b, *cln_g, *cln_b,
      *w_out, *ln1_g, *ln1_b, *wq, *pkeys, *pu, *pv, *ln2_g, *ln2_b;
  float* out;
  u16 *XB, *WINT, *WOUTT, *WQT, *W1KT, *W1VT, *W2KT, *W2VT, *PKEYS, *UB, *VB, *H, *VT, *KC, *VCT, *MIXB, *YB, *PQ;
  float *BIAS, *Y, *GW, *USC, *VSC;
  int* EIDX;
  unsigned* BAR;
  long long phase_lo, phase_hi;
};

typedef __bf16 bf16x2_hw __attribute__((ext_vector_type(2)));
typedef float f32x2_hw __attribute__((ext_vector_type(2)));
DI unsigned pack2(float lo, float hi) {
  const f32x2_hw v = {lo, hi};
  return __builtin_bit_cast(unsigned, __builtin_convertvector(v, bf16x2_hw));
}
DI u16 f2bf(float x) { return (u16)(pack2(x, 0.f) & 0xffffu); }
DI float bf2f(u16 b) { return __uint_as_float(((unsigned)b) << 16); }
DI float bflo(unsigned u) { return __uint_as_float(u << 16); }
DI float bfhi(unsigned u) { return __uint_as_float(u & 0xffff0000u); }
DI float sigmoidf_(float x) { return __builtin_amdgcn_rcpf(1.0f + __expf(-x)); }
DI float gelu_tanh(float x) {
  float z = 0.7978845608028654f * (x + 0.044715f * x * x * x);
  float t = 1.0f - 2.0f * __builtin_amdgcn_rcpf(__expf(2.0f * z) + 1.0f);
  return 0.5f * x * (1.0f + t);
}
DI float q16f(float v, bool sum) {
  auto r = __builtin_amdgcn_permlane16_swap(__float_as_uint(v), __float_as_uint(v), false, false);
  const float a = __uint_as_float(r[0]), b = __uint_as_float(r[1]);
  return sum ? a + b : fmaxf(a, b);
}
DI float q32f(float v, bool sum) {
  auto r = __builtin_amdgcn_permlane32_swap(__float_as_uint(v), __float_as_uint(v), false, false);
  const float a = __uint_as_float(r[0]), b = __uint_as_float(r[1]);
  return sum ? a + b : fmaxf(a, b);
}
DI float quad_maxf(float v) { return q32f(q16f(v, false), false); }
DI float quad_sumf(float v) { return q32f(q16f(v, true), true); }
DI int quad_maxi(int v) {
  auto r = __builtin_amdgcn_permlane16_swap((unsigned)v, (unsigned)v, false, false);
  v = max((int)r[0], (int)r[1]);
  auto s = __builtin_amdgcn_permlane32_swap((unsigned)v, (unsigned)v, false, false);
  return max((int)s[0], (int)s[1]);
}
DI int quad_mini(int v) {
  auto r = __builtin_amdgcn_permlane16_swap((unsigned)v, (unsigned)v, false, false);
  v = min((int)r[0], (int)r[1]);
  auto s = __builtin_amdgcn_permlane32_swap((unsigned)v, (unsigned)v, false, false);
  return min((int)s[0], (int)s[1]);
}
template <int CTRL> DI float dppf(float v) { return __int_as_float(__builtin_amdgcn_update_dpp(0, __float_as_int(v), CTRL, 0xf, 0xf, false)); }
DI float wave_sum(float v) {
  v += dppf<0xB1>(v);
  v += dppf<0x4E>(v);
  v += dppf<0x141>(v);
  v += dppf<0x140>(v);
  return quad_sumf(v);
}
template <int CTRL> DI unsigned dppu(unsigned v) { return (unsigned)__builtin_amdgcn_update_dpp(0, (int)v, CTRL, 0xf, 0xf, false); }
DI float wave_max(float v) {
  v = fmaxf(v, dppf<0xB1>(v)); v = fmaxf(v, dppf<0x4E>(v)); v = fmaxf(v, dppf<0x141>(v)); v = fmaxf(v, dppf<0x140>(v));
  return quad_maxf(v);
}
DI unsigned row_or(unsigned v) {
  v |= dppu<0xB1>(v); v |= dppu<0x4E>(v); v |= dppu<0x141>(v); v |= dppu<0x140>(v);
  return v;
}
DI float block_sum(float v, float* red) {
  v = wave_sum(v);
  if ((threadIdx.x & 63) == 0) red[threadIdx.x >> 6] = v;
  __syncthreads();
  float r = red[0] + red[1] + red[2] + red[3];
  __syncthreads();
  return r;
}
DI bf16x8 ld8(const u16* p) { return *(const bf16x8*)p; }
DI bf16x8 comb(uint2 lo, uint2 hi) {
  uint4 v = make_uint4(lo.x, lo.y, hi.x, hi.y);
  return __builtin_bit_cast(bf16x8, v);
}
DI bf16x8 packp(f32x4 a, f32x4 b) {
  uint4 v = make_uint4(pack2(a[0], a[1]), pack2(a[2], a[3]), pack2(b[0], b[1]), pack2(b[2], b[3]));
  return __builtin_bit_cast(bf16x8, v);
}

#define XB_TMO      128
#define XB_XCNT(j)  (256  + 64 * (j))
#define XB_XSUB(j)  (1280 + 64 * (j))
#define XB_XGEN(j)  (2304 + 64 * (j))
#define XB_TOP      3328
#define XB_TOPGEN   3392
#define XCD_BAR_WORDS 3456
#define XB_SPIN_CAP (1u << 22)
#define LAS __attribute__((address_space(3)))
DI unsigned xb_ld(unsigned* p)              { return __hip_atomic_load(p, __ATOMIC_RELAXED, __HIP_MEMORY_SCOPE_AGENT); }
DI unsigned xb_add(unsigned* p, unsigned v) { return __hip_atomic_fetch_add(p, v, __ATOMIC_RELAXED, __HIP_MEMORY_SCOPE_AGENT); }
DI unsigned xb_xcc_id() { return (unsigned)__builtin_amdgcn_s_getreg((3 << 11) | 20) & 0xFu; }
#define XB_SPIN(cond, bar) do { unsigned _sp = 0; while (cond) { __builtin_amdgcn_s_sleep(1); \
    if ((++_sp & 255u) == 0u) { if (xb_ld(&(bar)[XB_TMO])) break; if (_sp > XB_SPIN_CAP) { (void)xb_add(&(bar)[XB_TMO], 1u); break; } } } } while (0)
struct XcdBarrier { unsigned* bar; unsigned x; volatile LAS unsigned* st; };
DI XcdBarrier xcd_barrier_post(unsigned* bar, volatile LAS unsigned* st) {
  XcdBarrier b; b.bar = bar; b.x = xb_xcc_id(); b.st = st;
  if (threadIdx.x == 0) (void)xb_add(&bar[XB_XCNT(b.x)], 1u);
  return b;
}
DI void xcd_barrier_complete(unsigned* bar, unsigned x, unsigned& nloc, unsigned& nx) {
  const unsigned G = gridDim.x * gridDim.y * gridDim.z;
  unsigned sum, cnt, mine, sp = 0u;
  for (;;) {
    sum = 0u; cnt = 0u; mine = 0u;
#pragma unroll 1
    for (unsigned j = 0; j < 16; ++j) { const unsigned c = xb_ld(&bar[XB_XCNT(j)]); sum += c; cnt += (c > 0u) ? 1u : 0u; mine = (j == x) ? c : mine; }
    if (sum == G) break;
    __builtin_amdgcn_s_sleep(1);
    if ((++sp & 255u) == 0u) { if (xb_ld(&bar[XB_TMO])) break; if (sp > XB_SPIN_CAP) { (void)xb_add(&bar[XB_TMO], 1u); break; } }
  }
  nloc = mine > 0u ? mine : 1u; nx = cnt > 0u ? cnt : 1u;
}
DI void xcd_barrier(unsigned* const bar, volatile LAS unsigned* const bst) {
  const unsigned bx = xb_xcc_id();
  asm volatile("s_waitcnt vmcnt(0)" ::: "memory");
  __syncthreads();
  if (threadIdx.x == 0) {
    __builtin_amdgcn_s_waitcnt(0);
    unsigned nloc = bst[0], nx = bst[1];
    if (nloc == 0u) { xcd_barrier_complete(bar, bx, nloc, nx); bst[0] = nloc; bst[1] = nx; }
    const unsigned old = xb_add(&bar[XB_XSUB(bx)], 1u);
    const unsigned gen = old / nloc;
    if (old + 1u == (gen + 1u) * nloc) {
      __builtin_amdgcn_fence(__ATOMIC_RELEASE, "agent");
      asm volatile("s_waitcnt vmcnt(0)" ::: "memory");
      const unsigned og = xb_add(&bar[XB_TOP], 1u);
      const unsigned tg = og / nx;
      if (og + 1u == (tg + 1u) * nx) xb_add(&bar[XB_TOPGEN], 1u);
      else XB_SPIN(xb_ld(&bar[XB_TOPGEN]) == tg, bar);
      __builtin_amdgcn_fence(__ATOMIC_ACQUIRE, "agent");
      xb_add(&bar[XB_XGEN(bx)], 1u);
      asm volatile("s_waitcnt vmcnt(0)" ::: "memory");
    } else {
      XB_SPIN(xb_ld(&bar[XB_XGEN(bx)]) == gen, bar);
      __builtin_amdgcn_fence(__ATOMIC_ACQUIRE, "agent");
      asm volatile("s_waitcnt vmcnt(0)" ::: "memory");
    }
  }
  __syncthreads();
}

DI void cvt_f32_bf16(const float* __restrict__ src, u16* __restrict__ dst, size_t n8) {
  size_t i = (size_t)blockIdx.x * 256 + threadIdx.x, stride = (size_t)gridDim.x * 256;
  for (; i < n8; i += stride) {
    float4 a = ((const float4*)src)[2 * i], b = ((const float4*)src)[2 * i + 1];
    uint4 o = make_uint4(pack2(a.x, a.y), pack2(a.z, a.w), pack2(b.x, b.y), pack2(b.z, b.w));
    ((uint4*)dst)[i] = o;
  }
}
DI void transpose_cvt(const float* __restrict__ src, int R, int C, u16* __restrict__ dst, int Cpad, float* tile, int bid, int nb) {
  const int tid = threadIdx.x;
  const int tr = R / 64, tc = Cpad / 64;
  for (int it = bid; it < tr * tc; it += nb) {
    const int r0 = (it / tc) * 64, c0 = (it % tc) * 64;
#pragma unroll
    for (int ps = 0; ps < 4; ++ps) {
      int r = ps * 16 + (tid >> 4), c = (tid & 15) * 4;
      float4 v = make_float4(0.f, 0.f, 0.f, 0.f);
      if (c0 + c < C) v = *(const float4*)(src + (size_t)(r0 + r) * C + c0 + c);
      tile[(c + 0) * 65 + r] = v.x; tile[(c + 1) * 65 + r] = v.y; tile[(c + 2) * 65 + r] = v.z; tile[(c + 3) * 65 + r] = v.w;
    }
    __syncthreads();
    {
      int c = tid >> 2, part = tid & 3;
      const float* tp = tile + c * 65 + part * 16;
      uint4 o0 = make_uint4(pack2(tp[0], tp[1]), pack2(tp[2], tp[3]), pack2(tp[4], tp[5]), pack2(tp[6], tp[7]));
      uint4 o1 = make_uint4(pack2(tp[8], tp[9]), pack2(tp[10], tp[11]), pack2(tp[12], tp[13]), pack2(tp[14], tp[15]));
      uint4* dp = (uint4*)(dst + (size_t)(c0 + c) * R + r0 + part * 16);
      dp[0] = o0; dp[1] = o1;
    }
    __syncthreads();
  }
}

typedef float v32f __attribute__((ext_vector_type(32)));
typedef _Float16 v32h __attribute__((ext_vector_type(32)));
typedef unsigned v6u __attribute__((ext_vector_type(6)));
constexpr int ROWB = 1536;
DI void quant_rows_fp6(const float* __restrict__ src, unsigned char* __restrict__ dst, float* __restrict__ sc, int row0, int nrows) {
  const int lane = threadIdx.x & 63;
  for (int row = row0 + (threadIdx.x >> 6); row < row0 + nrows; row += 4) {
    const float* sp = src + (size_t)row * 2048 + lane * 4;
    float4 v[8];
    float am = 0.f;
#pragma unroll
    for (int j = 0; j < 8; ++j) {
      float4 t = *(const float4*)(sp + j * 256);
      v[j] = t;
      am = fmaxf(am, fmaxf(fmaxf(fabsf(t.x), fabsf(t.y)), fmaxf(fabsf(t.z), fabsf(t.w))));
    }
    am = wave_max(am);
    const float scale = am > 0.f ? 7.0f / am : 1.0f;
    if (lane == 0) sc[row] = am > 0.f ? am * (1.0f / 7.0f) : 1.0f;
    v32h h;
#pragma unroll
    for (int j = 0; j < 8; ++j) {
      h[j * 4 + 0] = (_Float16)(v[j].x * scale); h[j * 4 + 1] = (_Float16)(v[j].y * scale);
      h[j * 4 + 2] = (_Float16)(v[j].z * scale); h[j * 4 + 3] = (_Float16)(v[j].w * scale);
    }
    const v6u q = __builtin_amdgcn_cvt_scalef32_pk32_fp6_f16(h, 1.0f);
    unsigned char* dp = dst + (size_t)row * ROWB;
    *(uint4*)(dp + lane * 16) = make_uint4(q[0], q[1], q[2], q[3]);
    *(uint2*)(dp + 1024 + lane * 8) = make_uint2(q[4], q[5]);
  }
}

DI void phase_prep(const Params& p, float* lds) {
  cvt_f32_bf16(p.x, p.XB, (size_t)NTOK * D_MODEL / 8);
  for (int o = blockIdx.x * 256 + threadIdx.x; o < 16 * 8 * 4 * 64; o += gridDim.x * 256) {
    const int ln = o & 63, ks = (o >> 6) & 3, kt = (o >> 8) & 7, hc = o >> 11;
    const float* ksrc = p.pkeys + ((size_t)(hc * 128 + kt * 16 + (ln & 15))) * 128 + ks * 32 + (ln >> 4) * 8;
    const float4 a = *(const float4*)ksrc, b = *(const float4*)(ksrc + 4);
    *(uint4*)(p.PKEYS + (size_t)o * 8) = make_uint4(pack2(a.x, a.y), pack2(a.z, a.w), pack2(b.x, b.y), pack2(b.z, b.w));
  }
  transpose_cvt(p.w_in, 2048, D_IN, p.WINT, HS, lds, blockIdx.x, gridDim.x);
  for (int o = blockIdx.x * 256 + threadIdx.x; o < 2 * 65536; o += gridDim.x * 256) {
    const int kind = o >> 16, r = o & 65535;
    const int ln = r & 63, t = (r >> 6) & 15, ks = r >> 10;
    const float* wsrc = (kind ? p.w1_v : p.w1_k) + (size_t)(ks * 32 + (ln >> 4) * 8) * 256 + t * 16 + (ln & 15);
    uint4 v = make_uint4(pack2(wsrc[0], wsrc[256]), pack2(wsrc[512], wsrc[768]), pack2(wsrc[1024], wsrc[1280]), pack2(wsrc[1536], wsrc[1792]));
    *(uint4*)((kind ? p.W1VT : p.W1KT) + (size_t)r * 8) = v;
  }
  transpose_cvt(p.w2_k, 256, 64, p.W2KT, 64, lds, blockIdx.x, gridDim.x);
  transpose_cvt(p.w2_v, 256, 64, p.W2VT, 64, lds, blockIdx.x, gridDim.x);
}

constexpr int LDS_ROW = 72;
template <class Epi>
DI void gemm_tile(const u16* __restrict__ P, int ldp, const u16* __restrict__ Q, int ldq, int K,
                          int p0, int q0, u16* lds, Epi epi) {
  const int tid = threadIdx.x, lane = tid & 63, w = tid >> 6;
  const int wp = w & 1, wq = w >> 1;
  const int l15 = lane & 15, quad = lane >> 4;
  u16* sP = lds;
  u16* sQ = lds + 128 * LDS_ROW;
  f32x4 acc[4][4];
#pragma unroll
  for (int i = 0; i < 4; ++i)
#pragma unroll
    for (int j = 0; j < 4; ++j) acc[i][j] = f32x4{0.f, 0.f, 0.f, 0.f};
  const int srow = tid >> 3, scc = tid & 7;
  const u16* gp = P + (size_t)(p0 + srow) * ldp + scc * 8;
  const u16* gq = Q + (size_t)(q0 + srow) * ldq + scc * 8;
  const u16* gp1 = gp + (size_t)32 * ldp; const u16* gp2 = gp + (size_t)64 * ldp; const u16* gp3 = gp + (size_t)96 * ldp;
  const u16* gq1 = gq + (size_t)32 * ldq; const u16* gq2 = gq + (size_t)64 * ldq; const u16* gq3 = gq + (size_t)96 * ldq;
  uint4 rp0 = *(const uint4*)gp, rp1 = *(const uint4*)gp1, rp2 = *(const uint4*)gp2, rp3 = *(const uint4*)gp3;
  uint4 rq0 = *(const uint4*)gq, rq1 = *(const uint4*)gq1, rq2 = *(const uint4*)gq2, rq3 = *(const uint4*)gq3;
  uint4 sp0 = *(const uint4*)(gp + 64), sp1 = *(const uint4*)(gp1 + 64), sp2 = *(const uint4*)(gp2 + 64), sp3 = *(const uint4*)(gp3 + 64);
  uint4 sq0 = *(const uint4*)(gq + 64), sq1 = *(const uint4*)(gq1 + 64), sq2 = *(const uint4*)(gq2 + 64), sq3 = *(const uint4*)(gq3 + 64);
  u16* wP = sP + srow * LDS_ROW + scc * 8;
  u16* wQ = sQ + srow * LDS_ROW + scc * 8;
  const int nkt = K / 64;
#define GEMM_COMPUTE() \
  _Pragma("unroll") for (int ks = 0; ks < 2; ++ks) { \
    bf16x8 a[4], b[4]; \
    _Pragma("unroll") for (int i = 0; i < 4; ++i) { \
      a[i] = *(const bf16x8*)(sP + (wp * 64 + i * 16 + l15) * LDS_ROW + ks * 32 + quad * 8); \
      b[i] = *(const bf16x8*)(sQ + (wq * 64 + i * 16 + l15) * LDS_ROW + ks * 32 + quad * 8); } \
    _Pragma("unroll") for (int i = 0; i < 4; ++i) \
      _Pragma("unroll") for (int j = 0; j < 4; ++j) acc[i][j] = MFMA16(a[i], b[j], acc[i][j]); }
  for (int kt = 0; kt < nkt; kt += 2) {
    *(uint4*)(wP) = rp0; *(uint4*)(wP + 32 * LDS_ROW) = rp1; *(uint4*)(wP + 64 * LDS_ROW) = rp2; *(uint4*)(wP + 96 * LDS_ROW) = rp3;
    *(uint4*)(wQ) = rq0; *(uint4*)(wQ + 32 * LDS_ROW) = rq1; *(uint4*)(wQ + 64 * LDS_ROW) = rq2; *(uint4*)(wQ + 96 * LDS_ROW) = rq3;
    __syncthreads();
    if (kt + 2 < nkt) {
      const int ko = (kt + 2) * 64;
      rp0 = *(const uint4*)(gp + ko); rp1 = *(const uint4*)(gp1 + ko); rp2 = *(const uint4*)(gp2 + ko); rp3 = *(const uint4*)(gp3 + ko);
      rq0 = *(const uint4*)(gq + ko); rq1 = *(const uint4*)(gq1 + ko); rq2 = *(const uint4*)(gq2 + ko); rq3 = *(const uint4*)(gq3 + ko);
    }
    GEMM_COMPUTE()
    __syncthreads();
    *(uint4*)(wP) = sp0; *(uint4*)(wP + 32 * LDS_ROW) = sp1; *(uint4*)(wP + 64 * LDS_ROW) = sp2; *(uint4*)(wP + 96 * LDS_ROW) = sp3;
    *(uint4*)(wQ) = sq0; *(uint4*)(wQ + 32 * LDS_ROW) = sq1; *(uint4*)(wQ + 64 * LDS_ROW) = sq2; *(uint4*)(wQ + 96 * LDS_ROW) = sq3;
    __syncthreads();
    if (kt + 3 < nkt) {
      const int ko = (kt + 3) * 64;
      sp0 = *(const uint4*)(gp + ko); sp1 = *(const uint4*)(gp1 + ko); sp2 = *(const uint4*)(gp2 + ko); sp3 = *(const uint4*)(gp3 + ko);
      sq0 = *(const uint4*)(gq + ko); sq1 = *(const uint4*)(gq1 + ko); sq2 = *(const uint4*)(gq2 + ko); sq3 = *(const uint4*)(gq3 + ko);
    }
    GEMM_COMPUTE()
    __syncthreads();
  }
#undef GEMM_COMPUTE
#pragma unroll
  for (int i = 0; i < 4; ++i)
#pragma unroll
    for (int j = 0; j < 4; ++j)
      epi(p0 + wp * 64 + i * 16 + quad * 4, q0 + wq * 64 + j * 16 + l15, acc[i][j]);
}

template <class Epi>
DI void gemm_tile_big(const u16* __restrict__ P, int ldp, const u16* __restrict__ Q, int ldq, int K,
                      int p0, int q0, u16* lds, Epi epi) {
  const int tid = threadIdx.x, lane = tid & 63, w = tid >> 6;
  const int wp = w & 1, wq = w >> 1;
  const int l15 = lane & 15, quad = lane >> 4;
  u16* sP = lds;
  u16* sQ = lds + 128 * LDS_ROW;
  f32x4 acc[4][8];
#pragma unroll
  for (int i = 0; i < 4; ++i)
#pragma unroll
    for (int j = 0; j < 8; ++j) acc[i][j] = f32x4{0.f, 0.f, 0.f, 0.f};
  const int srow = tid >> 3, scc = tid & 7;
  const u16* gp = P + (size_t)(p0 + srow) * ldp + scc * 8;
  const u16* gq = Q + (size_t)(q0 + srow) * ldq + scc * 8;
  const size_t sp32 = (size_t)32 * ldp, sq32 = (size_t)32 * ldq;
  uint4 rp0 = *(const uint4*)gp, rp1 = *(const uint4*)(gp + sp32), rp2 = *(const uint4*)(gp + 2 * sp32), rp3 = *(const uint4*)(gp + 3 * sp32);
  uint4 rq0 = *(const uint4*)gq, rq1 = *(const uint4*)(gq + sq32), rq2 = *(const uint4*)(gq + 2 * sq32), rq3 = *(const uint4*)(gq + 3 * sq32);
  uint4 rq4 = *(const uint4*)(gq + 4 * sq32), rq5 = *(const uint4*)(gq + 5 * sq32), rq6 = *(const uint4*)(gq + 6 * sq32), rq7 = *(const uint4*)(gq + 7 * sq32);
  u16* wP = sP + srow * LDS_ROW + scc * 8;
  u16* wQ = sQ + srow * LDS_ROW + scc * 8;
  const int nkt = K / 64;
  for (int kt = 0; kt < nkt; ++kt) {
    *(uint4*)(wP) = rp0; *(uint4*)(wP + 32 * LDS_ROW) = rp1; *(uint4*)(wP + 64 * LDS_ROW) = rp2; *(uint4*)(wP + 96 * LDS_ROW) = rp3;
    *(uint4*)(wQ) = rq0; *(uint4*)(wQ + 32 * LDS_ROW) = rq1; *(uint4*)(wQ + 64 * LDS_ROW) = rq2; *(uint4*)(wQ + 96 * LDS_ROW) = rq3;
    *(uint4*)(wQ + 128 * LDS_ROW) = rq4; *(uint4*)(wQ + 160 * LDS_ROW) = rq5; *(uint4*)(wQ + 192 * LDS_ROW) = rq6; *(uint4*)(wQ + 224 * LDS_ROW) = rq7;
    __syncthreads();
    if (kt + 1 < nkt) {
      const int ko = (kt + 1) * 64;
      rp0 = *(const uint4*)(gp + ko); rp1 = *(const uint4*)(gp + sp32 + ko); rp2 = *(const uint4*)(gp + 2 * sp32 + ko); rp3 = *(const uint4*)(gp + 3 * sp32 + ko);
      rq0 = *(const uint4*)(gq + ko); rq1 = *(const uint4*)(gq + sq32 + ko); rq2 = *(const uint4*)(gq + 2 * sq32 + ko); rq3 = *(const uint4*)(gq + 3 * sq32 + ko);
      rq4 = *(const uint4*)(gq + 4 * sq32 + ko); rq5 = *(const uint4*)(gq + 5 * sq32 + ko); rq6 = *(const uint4*)(gq + 6 * sq32 + ko); rq7 = *(const uint4*)(gq + 7 * sq32 + ko);
    }
    {
#define LDA_(dst, ks) _Pragma("unroll") for (int i = 0; i < 4; ++i) dst[i] = *(const bf16x8*)(sP + (wp * 64 + i * 16 + l15) * LDS_ROW + (ks) * 32 + quad * 8)
#define LDB_(dst, ks, jh) _Pragma("unroll") for (int j = 0; j < 4; ++j) dst[j] = *(const bf16x8*)(sQ + (wq * 128 + ((jh) * 4 + j) * 16 + l15) * LDS_ROW + (ks) * 32 + quad * 8)
#define MM_(a, b, jh) do { __builtin_amdgcn_s_setprio(1); _Pragma("unroll") for (int i = 0; i < 4; ++i) _Pragma("unroll") for (int j = 0; j < 4; ++j) acc[i][(jh) * 4 + j] = MFMA16(a[i], b[j], acc[i][(jh) * 4 + j]); __builtin_amdgcn_s_setprio(0); } while (0)
#define SCHED_ __builtin_amdgcn_sched_barrier(0)
      bf16x8 a[4], b0[4], b1[4];
      LDA_(a, 0); LDB_(b0, 0, 0); LDB_(b1, 0, 1);
      SCHED_;
      MM_(a, b0, 0);
      SCHED_;
      LDB_(b0, 1, 0);
      SCHED_;
      MM_(a, b1, 1);
      SCHED_;
      LDA_(a, 1); LDB_(b1, 1, 1);
      SCHED_;
      MM_(a, b0, 0);
      SCHED_;
      MM_(a, b1, 1);
#undef LDA_
#undef LDB_
#undef MM_
#undef SCHED_
    }
    __syncthreads();
  }
#pragma unroll
  for (int i = 0; i < 4; ++i)
#pragma unroll
    for (int j = 0; j < 8; ++j)
      epi(p0 + wp * 64 + i * 16 + quad * 4, q0 + wq * 128 + j * 16 + l15, acc[i][j]);
}

template <class Epi>
DI void gemm_tile_glds(const u16* __restrict__ P, int ldp, const u16* __restrict__ Q, int ldq, int K,
                       int p0, int q0, unsigned char* lds, Epi epi) {
  const int tid = threadIdx.x, lane = tid & 63, w = tid >> 6;
  const int wp = w & 1, wq = w >> 1;
  const int l15 = lane & 15, quad = lane >> 4;
  f32x4 acc[4][4];
#pragma unroll
  for (int i = 0; i < 4; ++i)
#pragma unroll
    for (int j = 0; j < 4; ++j) acc[i][j] = f32x4{0.f, 0.f, 0.f, 0.f};
  const int srow = w * 8 + (lane >> 3);
  const int csrc = (lane & 7) ^ ((srow >> 1) & 7);
  const u16* gp = P + (size_t)(p0 + srow) * ldp + csrc * 8;
  const u16* gq = Q + (size_t)(q0 + srow) * ldq + csrc * 8;
  const unsigned dP = (unsigned)__builtin_amdgcn_readfirstlane((int)(unsigned)(size_t)(lds + (w * 8) * 128));
  const unsigned dQ = dP + 16384u;
#define GLDS16(gsrc_, ldsb_) do { unsigned keep_; \
    asm volatile("s_mov_b32 %0, m0\n\ts_mov_b32 m0, %2\n\ts_nop 0\n\tglobal_load_lds_dwordx4 %1, off\n\ts_mov_b32 m0, %0" \
                 : "=&s"(keep_) : "v"(gsrc_), "s"(ldsb_) : "memory"); } while (0)
#define GLDS_ISSUE(kt_, buf_) do { \
    _Pragma("unroll") for (int j = 0; j < 4; ++j) { \
      GLDS16(gp + (size_t)(32 * j) * ldp + (kt_) * 64, dP + (unsigned)(j * 4096 + (buf_) * 32768)); \
      GLDS16(gq + (size_t)(32 * j) * ldq + (kt_) * 64, dQ + (unsigned)(j * 4096 + (buf_) * 32768)); } } while (0)
  GLDS_ISSUE(0, 0);
  const int nkt = K / 64;
  const int sw = l15 >> 1;
  const unsigned char* rP = lds + (wp * 64 + l15) * 128;
  const unsigned char* rQ = lds + 16384 + (wq * 64 + l15) * 128;
  for (int kt = 0; kt < nkt; ++kt) {
    asm volatile("s_waitcnt vmcnt(0)" ::: "memory");
    __builtin_amdgcn_s_barrier();
    if (kt + 1 < nkt) GLDS_ISSUE(kt + 1, (kt + 1) & 1);
    const int bo = (kt & 1) * 32768;
#pragma unroll
    for (int ks = 0; ks < 2; ++ks) {
      const int co = ((ks * 4 + quad) ^ sw) * 16;
      bf16x8 a[4], b[4];
#pragma unroll
      for (int i = 0; i < 4; ++i) {
        a[i] = *(const bf16x8*)(rP + bo + i * 2048 + co);
        b[i] = *(const bf16x8*)(rQ + bo + i * 2048 + co);
      }
#pragma unroll
      for (int i = 0; i < 4; ++i)
#pragma unroll
        for (int j = 0; j < 4; ++j) acc[i][j] = MFMA16(a[i], b[j], acc[i][j]);
    }
  }
#undef GLDS_ISSUE
#undef GLDS16
  __syncthreads();
  if constexpr (Epi::kPairRows) {
#pragma unroll
    for (int j = 0; j < 4; ++j)
#pragma unroll
      for (int i = 0; i < 4; i += 2) {
        const unsigned alo = pack2(acc[i][j][0], acc[i][j][1]), ahi = pack2(acc[i][j][2], acc[i][j][3]);
        const unsigned blo = pack2(acc[i + 1][j][0], acc[i + 1][j][1]), bhi = pack2(acc[i + 1][j][2], acc[i + 1][j][3]);
        auto rl = __builtin_amdgcn_permlane16_swap(alo, blo, false, false);
        auto rh = __builtin_amdgcn_permlane16_swap(ahi, bhi, false, false);
        epi.store8(p0 + wp * 64 + (i + (quad & 1)) * 16 + (quad >> 1) * 8, q0 + wq * 64 + j * 16 + l15, make_uint4(rl[0], rh[0], rl[1], rh[1]));
      }
  } else {
#pragma unroll
    for (int i = 0; i < 4; ++i)
#pragma unroll
      for (int j = 0; j < 4; ++j)
        epi(p0 + wp * 64 + i * 16 + quad * 4, q0 + wq * 64 + j * 16 + l15, acc[i][j]);
  }
}

struct EpiH {
  static constexpr bool kPairRows = true;
  u16* H;
  DI void store8(int pch, int tok, uint4 v) const { *(uint4*)(H + (size_t)tok * HS + pch) = v; }
  DI void operator()(int pch, int tok, f32x4 v) const {
    *(uint2*)(H + (size_t)tok * HS + pch) = make_uint2(pack2(v[0], v[1]), pack2(v[2], v[3]));
  }
};
struct EpiVT {
  static constexpr bool kPairRows = false;
  u16* VT;
  DI void operator()(int tok, int ch, f32x4 v) const {
    int which = (ch >= 2304) ? 1 : 0;
    int cc = ch & 255;
    int g = cc >> 6, d = cc & 63;
    int b = tok >> 12, t = tok & 4095;
    *(uint2*)(VT + ((size_t)((which * 2 + b) * 4 + g) * 64 + d) * 4096 + t) = make_uint2(pack2(v[0], v[1]), pack2(v[2], v[3]));
  }
};
struct EpiMix {
  static constexpr bool kPairRows = false;
  float* Y; const float* x;
  DI void operator()(int c, int tok, f32x4 v) const {
    float4 xv = *(const float4*)(x + (size_t)tok * 2048 + c);
    *(float4*)(Y + (size_t)tok * 2048 + c) = make_float4(DN_ALPHA * xv.x + v[0], DN_ALPHA * xv.y + v[1], DN_ALPHA * xv.z + v[2], DN_ALPHA * xv.w + v[3]);
  }
};
struct EpiPQ {
  static constexpr bool kPairRows = false;
  u16* PQ;
  DI void operator()(int c, int tok, f32x4 v) const {
    const size_t off = ((((size_t)(tok >> 4) * 16 + (c >> 7)) * 4 + ((c >> 5) & 3)) * 64 + ((c >> 3) & 3) * 16 + (tok & 15)) * 8 + (c & 7);
    *(uint2*)(PQ + off) = make_uint2(pack2(v[0], v[1]), pack2(v[2], v[3]));
  }
};

DI void phase_gemm1(const Params& p, u16* lds, volatile LAS unsigned* bcast) {
  for (;;) {
    if (threadIdx.x == 0) bcast[2] = xb_add(&p.BAR[0], 1u);
    __syncthreads();
    const int it = (int)bcast[2];
    __syncthreads();
    if (it >= 37 * 64) break;
    const int ct = it % 37, tt = it / 37;
    const bool isv = (ct == 14 || ct == 15 || ct == 18 || ct == 19);
    if (isv) gemm_tile_glds(p.XB, 2048, p.WINT, 2048, 2048, tt * 128, ct * 128, (unsigned char*)lds, EpiVT{p.VT});
    else     gemm_tile_glds(p.WINT, 2048, p.XB, 2048, 2048, ct * 128, tt * 128, (unsigned char*)lds, EpiH{p.H});
  }
}
DI void phase_gemm_mix(const Params& p, u16* lds) {
  for (int it = blockIdx.x; it < 16 * 64; it += gridDim.x) {
    int ct = it % 16, tt = it / 16;
    gemm_tile_glds(p.WOUTT, 2048, p.MIXB, 2048, 2048, ct * 128, tt * 128, (unsigned char*)lds, EpiMix{p.Y, p.x});
  }
}
DI void phase_gemm_pq(const Params& p, u16* lds) {
  for (int it = blockIdx.x; it < 16 * 64; it += gridDim.x) {
    int ct = it % 16, tt = it / 16;
    gemm_tile_glds(p.WQT, 2048, p.YB, 2048, 2048, ct * 128, tt * 128, (unsigned char*)lds, EpiPQ{p.PQ});
  }
}

DI bf16x8 add_pos(bf16x8 v, float4 a, float4 b) {
  uint4 u = __builtin_bit_cast(uint4, v);
  uint4 r = make_uint4(pack2(bflo(u.x) + a.x, bfhi(u.x) + a.y), pack2(bflo(u.y) + a.z, bfhi(u.y) + a.w),
                       pack2(bflo(u.z) + b.x, bfhi(u.z) + b.y), pack2(bflo(u.w) + b.z, bfhi(u.w) + b.w));
  return __builtin_bit_cast(bf16x8, r);
}
DI void compress_item(const Params& p, int item, u16* hid  ) {
  const int tid = threadIdx.x, lane = tid & 63, w = tid >> 6;
  const int l15 = lane & 15, quad = lane >> 4;
  const int kind = item >> 6;
  const int r0 = (item & 63) * 32;
  const u16* W1T = kind ? p.W1VT : p.W1KT;
  const u16* W2T = kind ? p.W2VT : p.W2KT;
  const float* posp = (kind ? p.pos_v : p.pos_k) + quad * 8;
  const u16* brow[2];
#pragma unroll
  for (int qi = 0; qi < 2; ++qi) {
    int r = r0 + qi * 16 + l15;
    if (r > 2039) r = 2039;
    int g = r & 3, bn = r >> 2;
    int b = bn / 255, n = bn % 255;
    brow[qi] = p.H + (size_t)(b * 4096 + 16 * n) * HS + COL_KV + kind * 256 + g * 64 + quad * 8;
  }
  const u16* arow = W1T + ((size_t)(w * 4) * 64 + lane) * 8;
  f32x4 acc[4][2];
#pragma unroll
  for (int i = 0; i < 4; ++i) { acc[i][0] = f32x4{0.f, 0.f, 0.f, 0.f}; acc[i][1] = f32x4{0.f, 0.f, 0.f, 0.f}; }
#pragma unroll 4
  for (int ks = 0; ks < 64; ++ks) {
    const int l = ks >> 1, d0 = (ks & 1) * 32;
    const float4 pa = *(const float4*)(posp + l * 64 + d0), pb4 = *(const float4*)(posp + l * 64 + d0 + 4);
    bf16x8 b0 = add_pos(ld8(brow[0] + (size_t)l * HS + d0), pa, pb4);
    bf16x8 b1 = add_pos(ld8(brow[1] + (size_t)l * HS + d0), pa, pb4);
#pragma unroll
    for (int i = 0; i < 4; ++i) {
      bf16x8 a = ld8(arow + (size_t)(ks * 16 + i) * 512);
      acc[i][0] = MFMA16(a, b0, acc[i][0]);
      acc[i][1] = MFMA16(a, b1, acc[i][1]);
    }
  }
#pragma unroll
  for (int i = 0; i < 4; ++i)
#pragma unroll
    for (int qi = 0; qi < 2; ++qi) {
      int j = w * 64 + i * 16 + quad * 4;
      float h0 = gelu_tanh(acc[i][qi][0]), h1 = gelu_tanh(acc[i][qi][1]);
      float h2 = gelu_tanh(acc[i][qi][2]), h3 = gelu_tanh(acc[i][qi][3]);
      *(uint2*)(hid + (qi * 16 + l15) * 264 + j) = make_uint2(pack2(h0, h1), pack2(h2, h3));
    }
  __syncthreads();
  f32x4 o2[2] = {f32x4{0.f, 0.f, 0.f, 0.f}, f32x4{0.f, 0.f, 0.f, 0.f}};
#pragma unroll
  for (int ks = 0; ks < 8; ++ks) {
    bf16x8 a = ld8(W2T + (size_t)(w * 16 + l15) * 256 + ks * 32 + quad * 8);
#pragma unroll
    for (int qi = 0; qi < 2; ++qi) {
      bf16x8 b = *(const bf16x8*)(hid + (qi * 16 + l15) * 264 + ks * 32 + quad * 8);
      o2[qi] = MFMA16(a, b, o2[qi]);
    }
  }
#pragma unroll
  for (int qi = 0; qi < 2; ++qi) {
    int r = r0 + qi * 16 + l15;
    if (r < 2040) {
      int g = r & 3, bn = r >> 2;
      int b = bn / 255, n = bn % 255;
      int d = w * 16 + quad * 4;
      if (kind == 0) {
        *(uint2*)(p.KC + ((((size_t)(b * 4 + g) * 16 + (n >> 4)) * 2 + (d >> 5)) * 64 + ((d >> 3) & 3) * 16 + (n & 15)) * 8 + (d & 7)) = make_uint2(pack2(o2[qi][0], o2[qi][1]), pack2(o2[qi][2], o2[qi][3]));
      } else {
        const int m = n & 31;
        u16* vp = p.VCT + (((((size_t)(b * 4 + g) * 4 + (n >> 6)) * 2 + ((n >> 5) & 1)) * 4 + (d >> 4)) * 64 + ((m & 15) >> 2) * 16 + (d & 15)) * 8 + (m & 3) + ((m >> 4) << 2);
        vp[0] = f2bf(o2[qi][0]); vp[8] = f2bf(o2[qi][1]); vp[16] = f2bf(o2[qi][2]); vp[24] = f2bf(o2[qi][3]);
      }
    }
  }
  if ((item & 63) == 0) {
    if (kind == 0) {
      if (tid < 8 * 64) { int bg = tid >> 5;   (void)bg; }
      for (int e = tid; e < 8 * 64; e += 256) { const int bg = e >> 6, dd = e & 63; p.KC[((((size_t)bg * 16 + 15) * 2 + (dd >> 5)) * 64 + ((dd >> 3) & 3) * 16 + 15) * 8 + (dd & 7)] = 0; }
    } else {
      for (int e = tid; e < 8 * 64; e += 256) { const int bg = e >> 6, dd = e & 63; p.VCT[(((((size_t)bg * 4 + 3) * 2 + 1) * 4 + (dd >> 4)) * 64 + 3 * 16 + (dd & 15)) * 8 + 7] = 0; }
    }
  }
  __syncthreads();
}

constexpr int CT = 16;
DI void conv_item(const Params& p, int item, float* red) {
  const int tid = threadIdx.x;
  const int tok0 = item * CT;
  const int t0 = tok0 & 4095;
  const int c = tid * 4;
  float res[CT][4];
  {
    float4 bv = *(const float4*)(p.dw_b + c);
#pragma unroll
    for (int o = 0; o < CT; ++o) { res[o][0] = bv.x; res[o][1] = bv.y; res[o][2] = bv.z; res[o][3] = bv.w; }
  }
  {
    const int tt0 = (t0 >= 30) ? 0 : (30 - t0);
    const u16* hp = p.H + (size_t)(tok0 - 30 + tt0) * HS + COL_CONV + c;
    const float* wp = p.dw_w + c;
    float4 wr[CT];
#pragma unroll
    for (int o = 0; o < CT; ++o) {
      const int tap = tt0 - o;
      wr[o] = (tap >= 0 && tap <= 30) ? *(const float4*)(wp + tap * 1024) : make_float4(0.f, 0.f, 0.f, 0.f);
    }
#pragma unroll 8
    for (int tt = tt0; tt < 30 + CT; ++tt, hp += HS) {
      const uint2 av = *(const uint2*)hp;
      const uint2 gv = *(const uint2*)(hp + 1024);
      const float4 wnext = (tt + 1 <= 30) ? *(const float4*)(wp + (tt + 1) * 1024) : make_float4(0.f, 0.f, 0.f, 0.f);
      const float u0 = bflo(av.x) * sigmoidf_(bflo(gv.x));
      const float u1 = bfhi(av.x) * sigmoidf_(bfhi(gv.x));
      const float u2 = bflo(av.y) * sigmoidf_(bflo(gv.y));
      const float u3 = bfhi(av.y) * sigmoidf_(bfhi(gv.y));
#pragma unroll
      for (int o = 0; o < CT; ++o) {
        res[o][0] += wr[o].x * u0;
        res[o][1] += wr[o].y * u1;
        res[o][2] += wr[o].z * u2;
        res[o][3] += wr[o].w * u3;
      }
#pragma unroll
      for (int o = CT - 1; o > 0; --o) wr[o] = wr[o - 1];
      wr[0] = wnext;
    }
  }
  float mu[CT], rs[CT];
  {
    const int lane = tid & 63, w = tid >> 6;
#pragma unroll
    for (int o = 0; o < CT; ++o) {
      const float s = wave_sum(res[o][0] + res[o][1] + res[o][2] + res[o][3]);
      if (lane == 0) red[w * CT + o] = s;
    }
    __syncthreads();
#pragma unroll
    for (int o = 0; o < CT; ++o) mu[o] = (red[o] + red[CT + o] + red[2 * CT + o] + red[3 * CT + o]) * (1.0f / 1024.0f);
    __syncthreads();
#pragma unroll
    for (int o = 0; o < CT; ++o) {
      const float a = res[o][0] - mu[o], b = res[o][1] - mu[o], c2 = res[o][2] - mu[o], d = res[o][3] - mu[o];
      const float s = wave_sum(a * a + b * b + c2 * c2 + d * d);
      if (lane == 0) red[w * CT + o] = s;
    }
    __syncthreads();
#pragma unroll
    for (int o = 0; o < CT; ++o) rs[o] = rsqrtf((red[o] + red[CT + o] + red[2 * CT + o] + red[3 * CT + o]) * (1.0f / 1024.0f) + LN_EPS);
    __syncthreads();
  }
  {
    const float4 gv = *(const float4*)(p.cln_g + c), bv = *(const float4*)(p.cln_b + c);
#pragma unroll
    for (int o = 0; o < CT; ++o) {
      float y0 = (res[o][0] - mu[o]) * rs[o] * gv.x + bv.x;
      float y1 = (res[o][1] - mu[o]) * rs[o] * gv.y + bv.y;
      float y2 = (res[o][2] - mu[o]) * rs[o] * gv.z + bv.z;
      float y3 = (res[o][3] - mu[o]) * rs[o] * gv.w + bv.w;
      y0 = y0 * sigmoidf_(y0); y1 = y1 * sigmoidf_(y1); y2 = y2 * sigmoidf_(y2); y3 = y3 * sigmoidf_(y3);
      *(uint2*)(p.MIXB + (size_t)(tok0 + o) * 2048 + 1024 + c) = make_uint2(pack2(y0, y1), pack2(y2, y3));
    }
  }
}

DI void qk4(const u16* __restrict__ Kb, int kstride, int key0, bf16x8 qf0, bf16x8 qf1, f32x4 (&s)[4], int l15, int quad) {
#pragma unroll
  for (int kt = 0; kt < 4; ++kt) {
    const u16* kr = Kb + (size_t)(key0 + kt * 16 + l15) * kstride + quad * 8;
    bf16x8 a0 = ld8(kr), a1 = ld8(kr + 32);
    f32x4 z = f32x4{0.f, 0.f, 0.f, 0.f};
    z = MFMA16(a0, qf0, z);
    z = MFMA16(a1, qf1, z);
    s[kt] = z;
  }
}
DI void qk4f(const u16* __restrict__ KCF, int c, bf16x8 qf0, bf16x8 qf1, f32x4 (&s)[4], int lane) {
#pragma unroll
  for (int kt = 0; kt < 4; ++kt) {
    const u16* kr = KCF + ((size_t)((c * 4 + kt) * 2) * 64 + lane) * 8;
    bf16x8 a0 = ld8(kr), a1 = ld8(kr + 512);
    f32x4 z = f32x4{0.f, 0.f, 0.f, 0.f};
    z = MFMA16(a0, qf0, z);
    z = MFMA16(a1, qf1, z);
    s[kt] = z;
  }
}
DI void pv4(const u16* __restrict__ Vt, int vstride, int key0, const f32x4 (&s)[4], f32x4 (&o)[4], int l15, int quad) {
#pragma unroll
  for (int ks2 = 0; ks2 < 2; ++ks2) {
    bf16x8 pb = packp(s[2 * ks2], s[2 * ks2 + 1]);
#pragma unroll
    for (int dt = 0; dt < 4; ++dt) {
      const u16* vr = Vt + (size_t)(dt * 16 + l15) * vstride + key0 + ks2 * 32 + quad * 4;
      uint2 lo = *(const uint2*)vr, hi = *(const uint2*)(vr + 16);
      o[dt] = MFMA16(comb(lo, hi), pb, o[dt]);
    }
  }
}
DI void pv4f(const u16* __restrict__ VCF, int c, const f32x4 (&s)[4], f32x4 (&o)[4], int lane) {
#pragma unroll
  for (int ks2 = 0; ks2 < 2; ++ks2) {
    bf16x8 pb = packp(s[2 * ks2], s[2 * ks2 + 1]);
#pragma unroll
    for (int dt = 0; dt < 4; ++dt)
      o[dt] = MFMA16(ld8(VCF + ((size_t)(((c * 2 + ks2) * 4 + dt) * 64) + lane) * 8), pb, o[dt]);
  }
}
DI void flash_block(const u16* __restrict__ Kb, const u16* __restrict__ Vt, int key0, int tq, float slope, bool rowok, int win,
                    bf16x8 qf0, bf16x8 qf1, float& m, float& l, f32x4 (&o)[4], int l15, int quad) {
  f32x4 s[4];
  qk4(Kb, HS, key0, qf0, qf1, s, l15, quad);
  float bm = -1e30f;
#pragma unroll
  for (int kt = 0; kt < 4; ++kt)
#pragma unroll
    for (int i = 0; i < 4; ++i) {
      int dist = tq - (key0 + kt * 16 + quad * 4 + i);
      bool valid = rowok && dist >= 0 && dist < win;
      float sv = valid ? (s[kt][i] * 0.125f - slope * (float)dist) : -1e30f;
      s[kt][i] = sv;
      bm = fmaxf(bm, sv);
    }
  bm = quad_maxf(bm);
  const float mn = fmaxf(m, bm);
  const float alpha = __expf(m - mn);
  float ps = 0.f;
#pragma unroll
  for (int kt = 0; kt < 4; ++kt)
#pragma unroll
    for (int i = 0; i < 4; ++i) {
      float sv = s[kt][i];
      float pv = (sv > -1e29f) ? __expf(sv - mn) : 0.f;
      s[kt][i] = pv;
      ps += pv;
    }
  ps = quad_sumf(ps);
  l = l * alpha + ps;
  m = mn;
#pragma unroll
  for (int dt = 0; dt < 4; ++dt) { o[dt][0] *= alpha; o[dt][1] *= alpha; o[dt][2] *= alpha; o[dt][3] *= alpha; }
  pv4(Vt, 4096, key0, s, o, l15, quad);
}

DI void nsa_item(const Params& p, int item, float* implds  , unsigned char* kvlds  ) {
  const int tid = threadIdx.x, lane = tid & 63, w = tid >> 6;
  const int l15 = lane & 15, quad = lane >> 4;
  int qt = item & 255; const int g = (item >> 8) & 3, b = item >> 10;
  const int t0 = qt * 16, tq = t0 + w * 4 + (l15 >> 2);
  const int hh = g * 4 + (l15 & 3);
  const float slope = exp2f(-0.5f * (float)(hh + 1));
  const size_t tokbase = (size_t)b * 4096;
  const u16* Hq = p.H + (tokbase + tq) * HS + hh * 64;
  const bf16x8 qf0 = ld8(Hq + quad * 8), qf1 = ld8(Hq + 32 + quad * 8);
  const u16* gp = p.H + (tokbase + tq) * HS + COL_GATE + hh * 3;
  const float g0 = sigmoidf_(bf2f(gp[0])), g1 = sigmoidf_(bf2f(gp[1])), g2 = sigmoidf_(bf2f(gp[2]));

  const u16* KCb = p.KC + ((size_t)(b * 4 + g) * 256) * 64;
  const u16* VCTb = p.VCT + ((size_t)(b * 4 + g) * 64) * 256;
  const int nmax = (t0 - 16) >> 4;
  const int nch = (nmax < 0) ? 0 : ((nmax >> 6) + 1);
  float mc = -1e30f, lc = 0.f;
#pragma unroll 1
  for (int c = 0; c < nch; ++c) {
    f32x4 s[4];
    qk4f(KCb, c, qf0, qf1, s, lane);
    float bm = -1e30f;
#pragma unroll
    for (int kt = 0; kt < 4; ++kt)
#pragma unroll
      for (int i = 0; i < 4; ++i) {
        int ce = 16 * (c * 64 + kt * 16 + quad * 4 + i) + 31;
        float sv = (ce <= tq) ? (s[kt][i] * 0.125f - slope * (float)(tq - ce)) : -1e30f;
        s[kt][i] = sv;
        bm = fmaxf(bm, sv);
      }
    bm = quad_maxf(bm);
    const float mn = fmaxf(mc, bm);
    float ps = 0.f;
#pragma unroll
    for (int kt = 0; kt < 4; ++kt)
#pragma unroll
      for (int i = 0; i < 4; ++i) ps += (s[kt][i] > -1e29f) ? __expf(s[kt][i] - mn) : 0.f;
    ps = quad_sumf(ps);
    lc = lc * __expf(mc - mn) + ps;
    mc = mn;
  }
  const float inv = lc > 0.f ? 1.0f / lc : 0.f;
  f32x4 oacc[4];
#pragma unroll
  for (int dt = 0; dt < 4; ++dt) oacc[dt] = f32x4{0.f, 0.f, 0.f, 0.f};
  {
    float* lastlds = (float*)kvlds;
#pragma unroll 1
    for (int c = 0; c < 4; ++c) {
      f32x4 s[4];
      if (c < nch) {
        qk4f(KCb, c, qf0, qf1, s, lane);
#pragma unroll
        for (int kt = 0; kt < 4; ++kt)
#pragma unroll
          for (int i = 0; i < 4; ++i) {
            int ce = 16 * (c * 64 + kt * 16 + quad * 4 + i) + 31;
            float sv = s[kt][i] * 0.125f - slope * (float)(tq - ce);
            s[kt][i] = (ce <= tq) ? __expf(sv - mc) * inv : 0.f;
          }
        pv4f(VCTb, c, s, oacc, lane);
      } else {
#pragma unroll
        for (int kt = 0; kt < 4; ++kt) s[kt] = f32x4{0.f, 0.f, 0.f, 0.f};
      }
#pragma unroll
      for (int kt = 0; kt < 4; ++kt) {
        implds[(w * 16 + c * 4 + kt) * 64 + lane] = s[kt][0] + s[kt][1] + s[kt][2] + s[kt][3];
        lastlds[(w * 16 + c * 4 + kt) * 64 + lane] = s[kt][3];
      }
    }
  }
#pragma unroll
  for (int dt = 0; dt < 4; ++dt) { oacc[dt][0] *= g0; oacc[dt][1] *= g0; oacc[dt][2] *= g0; oacc[dt][3] *= g0; }
  const int cur = tq >> 6;
  u64 sel = 0;
  {
    int v[16];
#pragma unroll
    for (int jj = 0; jj < 16; ++jj) {
      const int j = jj * 4 + quad;
      float a = implds[(w * 16 + jj) * 64 + lane];
      {
        const float* lastlds = (const float*)kvlds;
        const int pj = (quad > 0) ? jj : jj - 1;
        const int pl = (quad > 0) ? lane - 16 : lane + 48;
        const float nbv = lastlds[(w * 16 + (pj < 0 ? 0 : pj)) * 64 + pl];
        a += (pj < 0) ? 0.f : nbv;
      }
      a += dppf<0xB1>(a);
      a += dppf<0x4E>(a);
      const bool forced = (j == 0) || (j == cur) || (j == cur - 1);
      if (forced) a += 1.0e4f;
      if (j * 64 > tq) a = -1.0f;
      v[jj] = (__float_as_int(a) & ~63) | (63 - j);
    }
#pragma unroll 1
    for (int r = 0; r < 16; ++r) {
      int bv = v[0];
#pragma unroll
      for (int jj = 1; jj < 16; ++jj) bv = max(bv, v[jj]);
      bv = quad_maxi(bv);
      sel |= 1ull << (63 - (bv & 63));
#pragma unroll
      for (int jj = 0; jj < 16; ++jj) v[jj] = (v[jj] == bv) ? (int)0x80000000 : v[jj];
    }
    if (cur < 63) sel &= ((1ull << (cur + 1)) - 1ull);
  }
  u64 U, Uw;
  {
    unsigned lo = (unsigned)sel, hi = (unsigned)(sel >> 32);
    lo = row_or(lo); hi = row_or(hi);
    lo = __builtin_amdgcn_readfirstlane(lo); hi = __builtin_amdgcn_readfirstlane(hi);
    Uw = ((u64)hi << 32) | lo;
    unsigned* ux = (unsigned*)(kvlds + 2 * 64 * 72 * 2);
    if (lane == 0) { ux[w * 2] = lo; ux[w * 2 + 1] = hi; }
    __syncthreads();
    lo = ux[0] | ux[2] | ux[4] | ux[6]; hi = ux[1] | ux[3] | ux[5] | ux[7];
    lo = __builtin_amdgcn_readfirstlane(lo); hi = __builtin_amdgcn_readfirstlane(hi);
    U = ((u64)hi << 32) | lo;
  }
  {
    float ms = -1e30f, ls = 0.f, mw = -1e30f, lw = 0.f;
    f32x4 os[4], ow[4];
#pragma unroll
    for (int dt = 0; dt < 4; ++dt) { os[dt] = f32x4{0.f, 0.f, 0.f, 0.f}; ow[dt] = f32x4{0.f, 0.f, 0.f, 0.f}; }
    int jw = t0 - 511; if (jw < 0) jw = 0; jw >>= 6;
    const int jhi = (t0 + 15) >> 6;
    const int nsteps = __builtin_popcountll(U) + (jhi - jw + 1);
    const float SL2 = slope * 1.4426950408889634f, QS = 0.125f * 1.4426950408889634f;
    const float aq = -SL2 * (float)tq;
    float cE[4][4];
#pragma unroll
    for (int kt = 0; kt < 4; ++kt)
#pragma unroll
      for (int i = 0; i < 4; ++i) cE[kt][i] = SL2 * (float)(kt * 16 + quad * 4 + i);
    u16* tiles = (u16*)kvlds;
    const int srow = tid >> 3, scc = tid & 7;
    const u16* kbl = p.H + (tokbase + srow) * HS + COL_KV + 2 * 256 + g * 64 + scc * 8;
    const u16* vbl = p.VT + ((size_t)((0 * 2 + b) * 4 + g) * 64 + srow) * 4096 + scc * 8;
    uint4 rk0, rk1, rv0, rv1;
    int nkind, nj;
#define NSA_NEXT() do { if (U) { nkind = 0; nj = __builtin_ctzll(U); U &= U - 1; } else { nkind = 1; nj = jw++; } } while (0)
#define NSA_FETCH() do { const u16* kb_ = kbl + (size_t)(nj * 64) * HS + nkind * 512; \
      const u16* vb_ = vbl + (size_t)nkind * (2 * 4 * 64 * 4096) + nj * 64; \
      rk0 = *(const uint4*)kb_; rk1 = *(const uint4*)(kb_ + (size_t)32 * HS); \
      rv0 = *(const uint4*)vb_; rv1 = *(const uint4*)(vb_ + (size_t)32 * 4096); } while (0)
    NSA_NEXT();
    NSA_FETCH();
#pragma unroll 1
    for (int st = 0; st < nsteps; ++st) {
      u16* sK = tiles + (st & 1) * (2 * 64 * 72);
      u16* sV = sK + 64 * 72;
      *(uint4*)(sK + srow * 72 + scc * 8) = rk0; *(uint4*)(sK + (srow + 32) * 72 + scc * 8) = rk1;
      *(uint4*)(sV + srow * 72 + scc * 8) = rv0; *(uint4*)(sV + (srow + 32) * 72 + scc * 8) = rv1;
      const int ckind = nkind, cj = nj;
      __syncthreads();
      if (st + 1 < nsteps) { NSA_NEXT(); NSA_FETCH(); }
      if (ckind || ((Uw >> cj) & 1ull)) {
      const int key0 = cj * 64;
      f32x4 s[4];
#pragma unroll
      for (int kt = 0; kt < 4; ++kt) {
        const u16* kr = sK + (kt * 16 + l15) * 72 + quad * 8;
        bf16x8 a0 = *(const bf16x8*)kr, a1 = *(const bf16x8*)(kr + 32);
        f32x4 z = f32x4{0.f, 0.f, 0.f, 0.f};
        z = MFMA16(a0, qf0, z);
        z = MFMA16(a1, qf1, z);
        s[kt] = z;
      }
      const float mold = ckind ? mw : ms;
      const float base = aq + SL2 * (float)key0;
      const int thr2 = tq - key0 - quad * 4;
      float bm = -1e30f;
      if (ckind) {
        const int thr3 = thr2 - 512;
#pragma unroll
        for (int kt = 0; kt < 4; ++kt)
#pragma unroll
          for (int i = 0; i < 4; ++i) {
            const float x = fmaf(s[kt][i], QS, base + cE[kt][i]);
            const bool valid = (kt * 16 + i <= thr2) && (kt * 16 + i > thr3);
            const float sv = valid ? x : -1e30f;
            s[kt][i] = sv;
            bm = fmaxf(bm, sv);
          }
      } else {
        const bool rowok = (bool)((sel >> cj) & 1ull);
#pragma unroll
        for (int kt = 0; kt < 4; ++kt)
#pragma unroll
          for (int i = 0; i < 4; ++i) {
            const float x = fmaf(s[kt][i], QS, base + cE[kt][i]);
            const bool valid = rowok && (kt * 16 + i <= thr2);
            const float sv = valid ? x : -1e30f;
            s[kt][i] = sv;
            bm = fmaxf(bm, sv);
          }
      }
      bm = quad_maxf(bm);
      const float mn = fmaxf(mold, bm);
      const float alpha = __builtin_amdgcn_exp2f(mold - mn);
      const float mne = fmaxf(mn, -1e20f);
      float ps = 0.f;
#pragma unroll
      for (int kt = 0; kt < 4; ++kt)
#pragma unroll
        for (int i = 0; i < 4; ++i) {
          const float pv = __builtin_amdgcn_exp2f(s[kt][i] - mne);
          s[kt][i] = pv;
          ps += pv;
        }
      ps = quad_sumf(ps);
      bf16x8 pb0 = packp(s[0], s[1]), pb1 = packp(s[2], s[3]);
      if (ckind) {
        lw = lw * alpha + ps; mw = mn;
#pragma unroll
        for (int dt = 0; dt < 4; ++dt) {
          ow[dt][0] *= alpha; ow[dt][1] *= alpha; ow[dt][2] *= alpha; ow[dt][3] *= alpha;
          const u16* vr = sV + (dt * 16 + l15) * 72 + quad * 4;
          ow[dt] = MFMA16(comb(*(const uint2*)vr, *(const uint2*)(vr + 16)), pb0, ow[dt]);
          ow[dt] = MFMA16(comb(*(const uint2*)(vr + 32), *(const uint2*)(vr + 48)), pb1, ow[dt]);
        }
      } else {
        ls = ls * alpha + ps; ms = mn;
#pragma unroll
        for (int dt = 0; dt < 4; ++dt) {
          os[dt][0] *= alpha; os[dt][1] *= alpha; os[dt][2] *= alpha; os[dt][3] *= alpha;
          const u16* vr = sV + (dt * 16 + l15) * 72 + quad * 4;
          os[dt] = MFMA16(comb(*(const uint2*)vr, *(const uint2*)(vr + 16)), pb0, os[dt]);
          os[dt] = MFMA16(comb(*(const uint2*)(vr + 32), *(const uint2*)(vr + 48)), pb1, os[dt]);
        }
      }
      }
    }
#undef NSA_NEXT
#undef NSA_FETCH
    __syncthreads();
    const float scs = g1 / ls, scw = g2 / lw;
#pragma unroll
    for (int dt = 0; dt < 4; ++dt) {
      oacc[dt][0] += scs * os[dt][0] + scw * ow[dt][0]; oacc[dt][1] += scs * os[dt][1] + scw * ow[dt][1];
      oacc[dt][2] += scs * os[dt][2] + scw * ow[dt][2]; oacc[dt][3] += scs * os[dt][3] + scw * ow[dt][3];
    }
  }
  u16* op = p.MIXB + (tokbase + tq) * 2048 + hh * 64 + quad * 4;
#pragma unroll
  for (int dt = 0; dt < 4; ++dt)
    *(uint2*)(op + dt * 16) = make_uint2(pack2(oacc[dt][0], oacc[dt][1]), pack2(oacc[dt][2], oacc[dt][3]));
}

DI void ln1_item(const Params& p, int item) {
  const int lane = threadIdx.x & 63, w = threadIdx.x >> 6;
  const int row = item * 4 + w;
  float* yr = p.Y + (size_t)row * 2048;
  float4 v[8];
  float s = 0.f;
#pragma unroll
  for (int i = 0; i < 8; ++i) { v[i] = *(const float4*)(yr + (lane + 64 * i) * 4); s += v[i].x + v[i].y + v[i].z + v[i].w; }
  const float mu = wave_sum(s) * (1.0f / 2048.0f);
  float q = 0.f;
#pragma unroll
  for (int i = 0; i < 8; ++i) { float a = v[i].x - mu, b = v[i].y - mu, c = v[i].z - mu, d = v[i].w - mu; q += a * a + b * b + c * c + d * d; }
  const float rs = rsqrtf(wave_sum(q) * (1.0f / 2048.0f) + LN_EPS);
#pragma unroll
  for (int i = 0; i < 8; ++i) {
    int c = (lane + 64 * i) * 4;
    float4 gv = *(const float4*)(p.ln1_g + c), bv = *(const float4*)(p.ln1_b + c);
    float4 o = make_float4((v[i].x - mu) * rs * gv.x + bv.x, (v[i].y - mu) * rs * gv.y + bv.y, (v[i].z - mu) * rs * gv.z + bv.z, (v[i].w - mu) * rs * gv.w + bv.w);
    *(float4*)(yr + c) = o;
    *(uint2*)(p.YB + (size_t)row * 2048 + c) = make_uint2(pack2(o.x, o.y), pack2(o.z, o.w));
  }
}

DI void peer_select_item(const Params& p, int item, float* lds) {
  const int lane = threadIdx.x & 63, w = threadIdx.x >> 6;
  const int l15 = lane & 15, quad = lane >> 4;
  const int tile = item >> 1, h = (item & 1) * 4 + w;
  const int tok = tile * 16 + l15;
  const u16* qfr = p.PQ + (((size_t)tile * 16 + h * 2) * 4 * 64 + lane) * 8;
  float* lv = lds + w * 1536;
  int* li = (int*)(lv + 512);
  float* tvl = lv + 1024;
  int* el = (int*)(lv + 1280);
#pragma unroll 1
  for (int c = 0; c < 2; ++c) {
    bf16x8 bq[4];
#pragma unroll
    for (int ks = 0; ks < 4; ++ks) bq[ks] = ld8(qfr + (size_t)((c * 4 + ks) * 64) * 8);
    const u16* kb = p.PKEYS + ((size_t)(h * 2 + c) * 2048 + lane) * 8;
    int a[32];
#pragma unroll
    for (int kt = 0; kt < 8; ++kt) {
      f32x4 z = f32x4{0.f, 0.f, 0.f, 0.f};
#pragma unroll
      for (int ks = 0; ks < 4; ++ks) z = MFMA16(ld8(kb + (size_t)(kt * 4 + ks) * 512), bq[ks], z);
#pragma unroll
      for (int i = 0; i < 4; ++i) {
        const int b = __float_as_int(z[i]);
        const int k = b ^ ((b >> 31) & 0x7fffffff);
        a[kt * 4 + i] = (k & ~127) | (127 - (kt * 16 + quad * 4 + i));
      }
    }
#pragma unroll
    for (int k = 2; k <= 32; k <<= 1) {
#pragma unroll
      for (int j = k >> 1; j > 0; j >>= 1) {
#pragma unroll
        for (int i = 0; i < 32; ++i) {
          const int l = i ^ j;
          if (l > i) {
            const bool desc = ((i & k) == 0);
            const int hi = max(a[i], a[l]), lo = min(a[i], a[l]);
            a[i] = desc ? hi : lo; a[l] = desc ? lo : hi;
          }
        }
      }
    }
#pragma unroll 1
    for (int r = 0; r < 16; ++r) {
      const int bk = quad_maxi(a[0]);
      if (quad == 0) {
        const int kv = bk & ~127;
        lv[(c * 16 + r) * 16 + l15] = __int_as_float(kv ^ ((kv >> 31) & 0x7fffffff));
        li[(c * 16 + r) * 16 + l15] = 127 - (bk & 127);
      }
      const bool win = (a[0] == bk);
#pragma unroll
      for (int i = 0; i < 15; ++i) a[i] = win ? a[i + 1] : a[i];
      a[15] = win ? (int)0x80000000 : a[15];
    }
  }
  __builtin_amdgcn_wave_barrier();
  float cv[13]; int cf[13];
#pragma unroll
  for (int k = 0; k < 13; ++k) {
    int a, bb; bool ok = true;
    if (k < 4) { a = 0; bb = k * 4 + quad; }
    else if (k < 6) { a = 1; bb = (k - 4) * 4 + quad; }
    else if (k == 6) { a = 2; bb = quad; }
    else if (k == 7) { a = 3; bb = quad; }
    else if (k == 8) { a = 8 + quad; bb = 0; }
    else if (k == 9) { a = 12 + quad; bb = 0; }
    else if (k == 10) { a = 4 + quad; bb = 0; }
    else if (k == 11) { a = 4 + quad; bb = 1; }
    else { a = (quad == 0) ? 2 : 4; bb = (quad == 0) ? 4 : 2; ok = quad < 2; }
    float v = lv[(0 * 16 + a) * 16 + l15] + lv[(1 * 16 + bb) * 16 + l15];
    cv[k] = ok ? v : -3.0e38f;
    cf[k] = ok ? (a * 16 + bb) : 999;
  }
  float tmax = 0.f, sum = 0.f;
#pragma unroll 1
  for (int r = 0; r < 16; ++r) {
    float bv = cv[0];
#pragma unroll
    for (int k = 1; k < 13; ++k) bv = fmaxf(bv, cv[k]);
    bv = quad_maxf(bv);
    int bi = 1000;
#pragma unroll
    for (int k = 0; k < 13; ++k) bi = (cv[k] == bv) ? min(bi, cf[k]) : bi;
    bi = quad_mini(bi);
    if (r == 0) tmax = bv;
    const float e = __expf(bv - tmax);
    sum += e;
    if (quad == 0) {
      const int a = bi >> 4, bb = bi & 15;
      el[r * 16 + l15] = li[(0 * 16 + a) * 16 + l15] * 128 + li[(1 * 16 + bb) * 16 + l15];
      tvl[r * 16 + l15] = e;
    }
#pragma unroll
    for (int k = 0; k < 13; ++k) cv[k] = (cf[k] == bi) ? -3.0e38f : cv[k];
  }
  __builtin_amdgcn_wave_barrier();
  {
    const float isum = 1.0f / sum;
    int* ep = p.EIDX + (size_t)tok * 128 + h * 16 + quad * 4;
    float* gw = p.GW + (size_t)tok * 128 + h * 16 + quad * 4;
    const int r0 = quad * 4;
    *(int4*)ep = make_int4(el[(r0 + 0) * 16 + l15], el[(r0 + 1) * 16 + l15], el[(r0 + 2) * 16 + l15], el[(r0 + 3) * 16 + l15]);
    *(float4*)gw = make_float4(tvl[(r0 + 0) * 16 + l15] * isum, tvl[(r0 + 1) * 16 + l15] * isum, tvl[(r0 + 2) * 16 + l15] * isum, tvl[(r0 + 3) * 16 + l15] * isum);
  }
  __builtin_amdgcn_wave_barrier();
}

#ifndef GB
#define GB 16
#endif
DI void peer_gather_item(const Params& p, int item, float* lds  ) {
  const int tid = threadIdx.x, lane = tid & 63, w = tid >> 6;
  const int tok = item * 4 + w;
  float* coef = lds + w * 128;
  int* idl = (int*)(lds + 512) + w * 128;
  const float* yrow = p.Y + (size_t)tok * 2048 + lane * 4;
  const int* eix = p.EIDX + (size_t)tok * 128;
  const float* gwp = p.GW + (size_t)tok * 128;
  const unsigned char* UBq = (const unsigned char*)p.UB;
  const unsigned char* VBq = (const unsigned char*)p.VB;
  float* usl = lds + 1024 + w * 128;
  float* csl = lds + 1536 + w * 128;
  {
    const int e0 = p.EIDX[(size_t)tok * 128 + lane], e1 = p.EIDX[(size_t)tok * 128 + 64 + lane];
    idl[lane] = e0; idl[64 + lane] = e1;
    usl[lane] = p.USC[e0]; usl[64 + lane] = p.USC[e1];
    csl[lane] = gwp[lane] * p.VSC[e0]; csl[64 + lane] = gwp[64 + lane] * p.VSC[e1];
  }
  float y[32];
#pragma unroll
  for (int j = 0; j < 8; ++j) {
    float4 a = *(const float4*)(yrow + j * 256);
    y[j * 4 + 0] = a.x; y[j * 4 + 1] = a.y; y[j * 4 + 2] = a.z; y[j * 4 + 3] = a.w;
  }
#pragma unroll 1
  for (int e8 = 0; e8 < 128; e8 += GB) {
    uint4 ra[GB]; uint2 rb[GB];
    int idx[GB];
#pragma unroll
    for (int u = 0; u < GB; ++u) {
      idx[u] = __builtin_amdgcn_readfirstlane(idl[e8 + u]);
      const unsigned char* up = UBq + (size_t)idx[u] * ROWB;
      ra[u] = *(const uint4*)(up + lane * 16);
      rb[u] = *(const uint2*)(up + 1024 + lane * 8);
    }
#pragma unroll
    for (int u = 0; u < GB; ++u) {
      const v6u q = {ra[u].x, ra[u].y, ra[u].z, ra[u].w, rb[u].x, rb[u].y};
      const v32f dv = __builtin_amdgcn_cvt_scalef32_pk32_f32_fp6(q, 1.0f);
      float d0 = 0.f, d1 = 0.f, d2 = 0.f, d3 = 0.f;
#pragma unroll
      for (int k = 0; k < 32; k += 4) { d0 += y[k] * dv[k]; d1 += y[k + 1] * dv[k + 1]; d2 += y[k + 2] * dv[k + 2]; d3 += y[k + 3] * dv[k + 3]; }
      const float d = wave_sum((d0 + d1) + (d2 + d3)) * usl[e8 + u];
      const float cval = gelu_tanh(d) * csl[e8 + u];
      if (lane == 0) coef[e8 + u] = cval;
    }
  }
  float acc[32];
#pragma unroll
  for (int i = 0; i < 32; ++i) acc[i] = DN_ALPHA * y[i];
#pragma unroll 1
  for (int e8 = 0; e8 < 128; e8 += GB) {
    uint4 ra[GB]; uint2 rb[GB];
    float cf[GB];
#pragma unroll
    for (int u = 0; u < GB; ++u) {
      const int idx = __builtin_amdgcn_readfirstlane(idl[e8 + u]);
      cf[u] = coef[e8 + u];
      const unsigned char* vp = VBq + (size_t)idx * ROWB;
      ra[u] = *(const uint4*)(vp + lane * 16);
      rb[u] = *(const uint2*)(vp + 1024 + lane * 8);
    }
#pragma unroll
    for (int u = 0; u < GB; ++u) {
      const v6u q = {ra[u].x, ra[u].y, ra[u].z, ra[u].w, rb[u].x, rb[u].y};
      const v32f dv = __builtin_amdgcn_cvt_scalef32_pk32_f32_fp6(q, 1.0f);
#pragma unroll
      for (int k = 0; k < 32; ++k) acc[k] += cf[u] * dv[k];
    }
  }
  float s = 0.f;
#pragma unroll
  for (int i = 0; i < 32; ++i) s += acc[i];
  const float mu = wave_sum(s) * (1.0f / 2048.0f);
  float qv = 0.f;
#pragma unroll
  for (int i = 0; i < 32; ++i) { float d = acc[i] - mu; qv += d * d; }
  const float rs = rsqrtf(wave_sum(qv) * (1.0f / 2048.0f) + LN_EPS);
  float* op = p.out + (size_t)tok * 2048 + lane * 4;
#pragma unroll
  for (int j = 0; j < 8; ++j) {
    const float4 gv = *(const float4*)(p.ln2_g + j * 256 + lane * 4), bv = *(const float4*)(p.ln2_b + j * 256 + lane * 4);
    *(float4*)(op + j * 256) = make_float4((acc[j * 4 + 0] - mu) * rs * gv.x + bv.x, (acc[j * 4 + 1] - mu) * rs * gv.y + bv.y,
                                         (acc[j * 4 + 2] - mu) * rs * gv.z + bv.z, (acc[j * 4 + 3] - mu) * rs * gv.w + bv.w);
  }
}

constexpr int LDS_BYTES = 65536;
__global__ void __launch_bounds__(256, 2) mega(Params p) {
  __shared__ __attribute__((aligned(16))) unsigned char smem[LDS_BYTES];
  __shared__ uint4 xb_words;
  const int lo = (int)p.phase_lo, hi = (int)p.phase_hi;
  if (threadIdx.x == 0) xb_words = make_uint4(0u, 0u, 0u, 0u);
  __syncthreads();
  volatile LAS unsigned* const xst = (volatile LAS unsigned*)&xb_words;
  if (threadIdx.x == 0) (void)xb_add(&p.BAR[XB_XCNT(xb_xcc_id())], 1u);
  if (lo > 1000) cg::this_grid().sync();
#ifdef ONLY_PHASE
#define PH_ON(n) ((n) == ONLY_PHASE)
#else
#define PH_ON(n) true
#endif
#ifndef REP_MASK
#define REP_MASK 0
#endif
#define PH_BEGIN(n) if (PH_ON(n) && lo <= (n) && (n) < hi) { if ((n) > lo) xcd_barrier(p.BAR, xst); for (int rep_ = 0; rep_ < 1 + ((REP_MASK >> (n)) & 1); ++rep_) {
#define PH_END } }
  PH_BEGIN(0) phase_prep(p, (float*)smem); PH_END
  PH_BEGIN(1) phase_gemm1(p, (u16*)smem, xst); PH_END
  PH_BEGIN(2)
    for (int it = blockIdx.x; it < 128; it += gridDim.x) compress_item(p, it, (u16*)smem);
    for (;;) {
      if (threadIdx.x == 0) xst[2] = xb_add(&p.BAR[2], 1u);
      __syncthreads();
      const int k = (int)xst[2];
      __syncthreads();
      if (k >= NTOK / CT) break;
      conv_item(p, k, (float*)smem);
    }
  PH_END
  PH_BEGIN(3)
    if (blockIdx.x % 5 == 0) {
      const int nq = (gridDim.x + 4) / 5;
      for (int c = blockIdx.x / 5; c < 512; c += nq) {
        if (c < 256) quant_rows_fp6(p.pu, (unsigned char*)p.UB, p.USC, c * 64, 64);
        else         quant_rows_fp6(p.pv, (unsigned char*)p.VB, p.VSC, (c - 256) * 64, 64);
      }
      transpose_cvt(p.w_out, 2048, 2048, p.WOUTT, 2048, (float*)smem, blockIdx.x / 5, nq);
      transpose_cvt(p.wq, 2048, 2048, p.WQT, 2048, (float*)smem, blockIdx.x / 5, nq);
    }
    for (;;) {
      if (threadIdx.x == 0) xst[2] = xb_add(&p.BAR[1], 1u);
      __syncthreads();
      const int k = (int)xst[2];
      __syncthreads();
      if (k >= 2048) break;
      nsa_item(p, ((k & 7) << 8) | (255 - (k >> 3)), (float*)smem, smem + 16384);
    }
  PH_END
  PH_BEGIN(4) phase_gemm_mix(p, (u16*)smem); PH_END
  PH_BEGIN(5)
    for (int it = blockIdx.x; it < 2048; it += gridDim.x) ln1_item(p, it);
  PH_END
  PH_BEGIN(6) phase_gemm_pq(p, (u16*)smem); PH_END
  PH_BEGIN(7)
    for (int it = blockIdx.x; it < 1024; it += gridDim.x) peer_select_item(p, it, (float*)smem);
  PH_END
  PH_BEGIN(8)
    for (int it = blockIdx.x; it < NTOK / 4; it += gridDim.x) peer_gather_item(p, it, (float*)smem);
  PH_END
}

extern "C" void kernel_launch(void* const* d_in, const int* in_sizes, int n_in, void* d_out, int out_size,
                              void* d_ws, size_t ws_size, hipStream_t stream) {
  Params p{};
  const float** f = (const float**)&p;
  for (int i = 0; i < 21; ++i) f[i] = (const float*)d_in[i];
  p.out = (float*)d_out;
  unsigned char* ws = (unsigned char*)d_ws;
  size_t off = 0;
  auto take = [&](size_t bytes) { unsigned char* r = ws + off; off += (bytes + 255) & ~(size_t)255; return r; };
  p.XB = (u16*)take((size_t)NTOK * 2048 * 2);
  p.WINT = (u16*)take((size_t)HS * 2048 * 2);
  p.WOUTT = (u16*)take((size_t)2048 * 2048 * 2);
  p.WQT = (u16*)take((size_t)2048 * 2048 * 2);
  p.W1KT = (u16*)take((size_t)256 * 2048 * 2);
  p.W1VT = (u16*)take((size_t)256 * 2048 * 2);
  p.W2KT = (u16*)take((size_t)64 * 256 * 2);
  p.W2VT = (u16*)take((size_t)64 * 256 * 2);
  p.PKEYS = (u16*)take((size_t)8 * 2 * 128 * 128 * 2);
  p.UB = (u16*)take((size_t)16384 * ROWB);
  p.VB = (u16*)take((size_t)16384 * ROWB);
  p.USC = (float*)take(16384 * 4);
  p.VSC = (float*)take(16384 * 4);
  p.H = (u16*)take((size_t)NTOK * HS * 2);
  p.VT = (u16*)take((size_t)2 * 2 * 4 * 64 * 4096 * 2);
  p.KC = (u16*)take((size_t)8 * 256 * 64 * 2);
  p.VCT = (u16*)take((size_t)8 * 64 * 256 * 2);
  p.MIXB = (u16*)take((size_t)NTOK * 2048 * 2);
  p.BIAS = (float*)take(512 * 4);
  p.Y = (float*)take((size_t)NTOK * 2048 * 4);
  p.GW = (float*)take((size_t)NTOK * 128 * 4);
  p.EIDX = (int*)take((size_t)NTOK * 128 * 4);
  p.BAR = (unsigned*)take(XCD_BAR_WORDS * 4);
  p.YB = p.XB;
  p.PQ = p.MIXB;
  if (off > ws_size) { fprintf(stderr, "kernel_launch: workspace too small (%zu > %zu)\n", off, ws_size); return; }

  static int grid_blocks = 0;
  if (!grid_blocks) {
    int dev = 0, cus = 0, per_cu = 0;
    hipGetDevice(&dev);
    hipDeviceGetAttribute(&cus, hipDeviceAttributeMultiprocessorCount, dev);
    hipOccupancyMaxActiveBlocksPerMultiprocessor(&per_cu, mega, 256, 0);
    if (per_cu < 1) per_cu = 1;
    grid_blocks = cus * per_cu;
  }
  (void)hipMemsetAsync(p.BAR, 0, XCD_BAR_WORDS * 4, stream);
#if N_LAUNCH_MODE == 1
  p.phase_lo = 0; p.phase_hi = NPHASE;
  void* args[] = {&p};
  hipError_t e = hipLaunchCooperativeKernel((void*)mega, dim3(grid_blocks), dim3(256), args, 0, stream);
  if (e != hipSuccess) fprintf(stderr, "cooperative launch failed: %s (grid %d)\n", hipGetErrorString(e), grid_blocks);
#else
  for (int ph = 0; ph < NPHASE; ++ph) {
    p.phase_lo = ph; p.phase_hi = ph + 1;
    hipLaunchKernelGGL(mega, dim3(grid_blocks), dim3(256), 0, stream, p);
  }
#endif
}
```
